# Optimizing an MI355X kernel written in HIP

```python
import jax, jax.numpy as jnp
from jax import lax
import numpy as np

D_MODEL = 2048
BATCH = 4
SEQ = 2048
DEPTH = 1

HG_HEADS = 8
HG_HEAD_DIM = 128
HG_WIDTH = HG_HEADS * HG_HEAD_DIM
ML_HEADS = 4
ML_QK_DIM = 128
ML_V_DIM = 256
ML_QK_WIDTH = ML_HEADS * ML_QK_DIM
ML_V_WIDTH = ML_HEADS * ML_V_DIM
ML_CONV = 4
CHUNK = 64
D_FF = 5632
FFN_CONV = 3
EPS = 1e-6
SPLIT_SIZES = (HG_WIDTH, HG_WIDTH, HG_WIDTH, HG_WIDTH, 2 * ML_QK_WIDTH, ML_V_WIDTH, ML_V_WIDTH, ML_HEADS, ML_HEADS, D_MODEL, D_MODEL)
IN_WIDTH = sum(SPLIT_SIZES)
FG_OFFSET = sum(SPLIT_SIZES[:8])

kernel_name = "hybrid_hgrn2_mlstm_convffn_block"


def rms_norm(u, gain):
    u32 = u.astype(jnp.float32)
    y = u32 * lax.rsqrt(jnp.mean(u32 * u32, axis=-1, keepdims=True) + EPS)
    return (y * gain.astype(jnp.float32)).astype(u.dtype)


def head_rms_norm(u, n_heads, gain):
    B, T, W = u.shape
    uh = u.reshape(B, T, n_heads, W // n_heads)
    uh = uh * lax.rsqrt(jnp.mean(uh * uh, axis=-1, keepdims=True) + EPS)
    return uh.reshape(B, T, W) * gain.astype(jnp.float32)


def causal_dwconv(u, w, bias):
    K = w.shape[0]
    T = u.shape[1]
    up = jnp.pad(u, ((0, 0), (K - 1, 0), (0, 0)))
    out = bias
    for j in range(K):
        out = out + w[j] * up[:, j:j + T]
    return out


def to_chunks(t, n_heads):
    B, T, W = t.shape
    return t.reshape(B, T // CHUNK, CHUNK, n_heads, W // n_heads).transpose(0, 3, 1, 2, 4)


def from_chunks(t):
    B, H, N, C, d = t.shape
    return t.transpose(0, 2, 3, 1, 4).reshape(B, N * C, H * d)


def gate_chunks(g):
    B, T, H = g.shape
    return g.reshape(B, T // CHUNK, CHUNK, H).transpose(0, 3, 1, 2)


def hgrn2_mix(q_pre, f_pre, i_in, g_pre, lb, gain):
    B = q_pre.shape[0]
    q = jax.nn.silu(q_pre) * (HG_HEAD_DIM ** -0.5)
    f = lb + (1.0 - lb) * jax.nn.sigmoid(f_pre)
    k = 1.0 - f
    q, k, v, log_f = to_chunks(q, HG_HEADS), to_chunks(k, HG_HEADS), to_chunks(i_in, HG_HEADS), to_chunks(jnp.log(f), HG_HEADS)
    b = jnp.cumsum(log_f, axis=3)
    b_last = b[:, :, :, -1]
    q_dec = q * jnp.exp(b)
    k_inv = k * jnp.exp(-b)
    k_end = k * jnp.exp(b_last[:, :, :, None] - b)
    causal = jnp.tril(jnp.ones((CHUNK, CHUNK), dtype=bool))
    attn = jnp.where(causal, jnp.einsum("bhntd,bhnsd->bhnts", q_dec, k_inv), 0.0)
    o_intra = jnp.einsum("bhnts,bhnse->bhnte", attn, v)

    def step(S, inp):
        decay, kc, vc = inp
        S_new = decay[..., None] * S + jnp.einsum("bhcd,bhce->bhde", kc, vc)
        return S_new, S

    S0 = jnp.zeros((B, HG_HEADS, HG_HEAD_DIM, HG_HEAD_DIM), jnp.float32)
    xs = (jnp.moveaxis(jnp.exp(b_last), 2, 0), jnp.moveaxis(k_end, 2, 0), jnp.moveaxis(v, 2, 0))
    _, S_prev = lax.scan(step, S0, xs)
    o_inter = jnp.einsum("bhntd,nbhde->bhnte", q_dec, S_prev)
    o = from_chunks(o_intra + o_inter)
    return head_rms_norm(o, HG_HEADS, gain) * jax.nn.silu(g_pre)


def mlstm_mix(q_in, k_in, v_in, o_pre, ig_pre, fg_pre, gain):
    B = q_in.shape[0]
    q = to_chunks(q_in, ML_HEADS)
    k = to_chunks(k_in, ML_HEADS) * (ML_QK_DIM ** -0.5)
    v = to_chunks(v_in, ML_HEADS)
    ig = gate_chunks(ig_pre)
    log_f = jax.nn.log_sigmoid(gate_chunks(fg_pre))
    b = jnp.cumsum(log_f, axis=-1)
    b_last = b[..., -1]
    logw = b_last[..., None] - b + ig

    def step(carry, inp):
        C, n, m = carry
        bl, lw, kc, vc = inp
        m_new = jnp.maximum(bl + m, jnp.max(lw, axis=-1))
        decay = jnp.exp(bl + m - m_new)
        w = jnp.exp(lw - m_new[..., None])
        C_new = decay[..., None, None] * C + jnp.einsum("bhc,bhcd,bhce->bhde", w, kc, vc)
        n_new = decay[..., None] * n + jnp.einsum("bhc,bhcd->bhd", w, kc)
        return (C_new, n_new, m_new), (C, n, m)

    init = (jnp.zeros((B, ML_HEADS, ML_QK_DIM, ML_V_DIM), jnp.float32),
            jnp.zeros((B, ML_HEADS, ML_QK_DIM), jnp.float32),
            jnp.zeros((B, ML_HEADS), jnp.float32))
    xs = (jnp.moveaxis(b_last, 2, 0), jnp.moveaxis(logw, 2, 0), jnp.moveaxis(k, 2, 0), jnp.moveaxis(v, 2, 0))
    _, (C_prev, n_prev, m_prev) = lax.scan(step, init, xs)
    m_prev = jnp.moveaxis(m_prev, 0, 2)

    causal = jnp.tril(jnp.ones((CHUNK, CHUNK), dtype=bool))
    log_d = jnp.where(causal, b[..., :, None] - b[..., None, :] + ig[..., None, :], -jnp.inf)
    m_inter = b + m_prev[..., None]
    m = jnp.maximum(m_inter, jnp.max(log_d, axis=-1))
    scores = jnp.einsum("bhntd,bhnsd->bhnts", q, k) * jnp.exp(log_d - m[..., None])
    inter_scale = jnp.exp(m_inter - m)
    num = jnp.einsum("bhnts,bhnse->bhnte", scores, v) + inter_scale[..., None] * jnp.einsum("bhntd,nbhde->bhnte", q, C_prev)
    den = jnp.sum(scores, axis=-1) + inter_scale * jnp.einsum("bhntd,nbhd->bhnt", q, n_prev)
    h = num / jnp.maximum(jnp.abs(den), jnp.exp(-m))[..., None]
    h = head_rms_norm(from_chunks(h), ML_HEADS, gain)
    return jax.nn.sigmoid(o_pre) * h


def setup_inputs(seed: int = 0) -> dict:
    key = jax.random.key(seed)
    ks = jax.random.split(key, 24)
    f32 = jnp.float32

    def nrm(k, shape, scale):
        return jax.random.normal(k, shape, f32) * scale

    def gains(k, shape):
        return 1.0 + nrm(k, shape, 0.05)

    b_in = nrm(ks[6], (DEPTH, IN_WIDTH), 0.02)
    b_in = b_in.at[:, FG_OFFSET:FG_OFFSET + ML_HEADS].add(jnp.linspace(3.0, 6.0, ML_HEADS, dtype=f32))
    return {
        "x": nrm(ks[0], (BATCH, SEQ, D_MODEL), 1.0),
        "norm_mix_pre": gains(ks[1], (DEPTH, D_MODEL)),
        "norm_mix_post": gains(ks[2], (DEPTH, D_MODEL)),
        "norm_ffn_pre": gains(ks[3], (DEPTH, D_MODEL)),
        "norm_ffn_post": gains(ks[4], (DEPTH, D_MODEL)),
        "w_in": nrm(ks[5], (DEPTH, D_MODEL, IN_WIDTH), D_MODEL ** -0.5),
        "b_in": b_in,
        "hg_lb_logits": nrm(ks[7], (DEPTH + 1, HG_WIDTH), 0.1),
        "hg_norm": gains(ks[8], (DEPTH, HG_WIDTH)),
        "ml_conv_w": nrm(ks[9], (DEPTH, ML_CONV, 2 * ML_QK_WIDTH), ML_CONV ** -0.5),
        "ml_conv_b": nrm(ks[10], (DEPTH, 2 * ML_QK_WIDTH), 0.02),
        "ml_norm": gains(ks[11], (DEPTH, ML_V_WIDTH)),
        "w_up_a": nrm(ks[12], (DEPTH, HG_WIDTH, D_MODEL), HG_WIDTH ** -0.5),
        "w_up_b": nrm(ks[13], (DEPTH, ML_V_WIDTH, D_MODEL), ML_V_WIDTH ** -0.5),
        "w_out": nrm(ks[14], (DEPTH, D_MODEL, D_MODEL), D_MODEL ** -0.5),
        "ffn_w_gate": nrm(ks[15], (DEPTH, D_MODEL, D_FF), D_MODEL ** -0.5),
        "ffn_w_up": nrm(ks[16], (DEPTH, D_MODEL, D_FF), D_MODEL ** -0.5),
        "ffn_conv_w": nrm(ks[17], (DEPTH, FFN_CONV, D_FF), FFN_CONV ** -0.5),
        "ffn_conv_b": nrm(ks[18], (DEPTH, D_FF), 0.02),
        "ffn_w_down": nrm(ks[19], (DEPTH, D_FF, D_MODEL), D_FF ** -0.5),
    }


def reference(x, norm_mix_pre, norm_mix_post, norm_ffn_pre, norm_ffn_post, w_in, b_in, hg_lb_logits,
              hg_norm, ml_conv_w, ml_conv_b, ml_norm, w_up_a, w_up_b, w_out, ffn_w_gate, ffn_w_up,
              ffn_conv_w, ffn_conv_b, ffn_w_down):
    f32 = jnp.float32
    split_points = [int(p) for p in np.cumsum(SPLIT_SIZES)[:-1]]
    lb_all = jnp.cumsum(jax.nn.softmax(hg_lb_logits.astype(f32), axis=0), axis=0)
    for l in range(DEPTH):
        h = rms_norm(x, norm_mix_pre[l])
        proj = jnp.einsum("btd,dp->btp", h, w_in[l]) + b_in[l]
        (hg_q, hg_f, hg_i, hg_g, ml_qk, ml_v, ml_o, ml_ig, ml_fg, gate_a, gate_b) = jnp.split(proj, split_points, axis=-1)
        y_a = hgrn2_mix(hg_q.astype(f32), hg_f.astype(f32), hg_i.astype(f32), hg_g.astype(f32), lb_all[l], hg_norm[l])
        ml_qk = jax.nn.silu(causal_dwconv(ml_qk, ml_conv_w[l], ml_conv_b[l]))
        ml_q, ml_k = jnp.split(ml_qk, 2, axis=-1)
        y_b = mlstm_mix(ml_q.astype(f32), ml_k.astype(f32), ml_v.astype(f32), ml_o.astype(f32),
                        ml_ig.astype(f32), ml_fg.astype(f32), ml_norm[l])
        branch_a = jnp.einsum("btc,cd->btd", y_a.astype(x.dtype), w_up_a[l])
        branch_b = jnp.einsum("btc,cd->btd", y_b.astype(x.dtype), w_up_b[l])
        merged = jax.nn.sigmoid(gate_a) * branch_a + jax.nn.sigmoid(gate_b) * branch_b
        mix_out = jnp.einsum("btd,de->bte", merged, w_out[l])
        x = x + rms_norm(mix_out, norm_mix_post[l])
        h = rms_norm(x, norm_ffn_pre[l])
        gate = causal_dwconv(jnp.einsum("btd,df->btf", h, ffn_w_gate[l]), ffn_conv_w[l], ffn_conv_b[l])
        up = jnp.einsum("btd,df->btf", h, ffn_w_up[l])
        ffn_out = jnp.einsum("btf,fd->btd", jax.nn.gelu(gate, approximate=True) * up, ffn_w_down[l])
        x = x + rms_norm(ffn_out, norm_ffn_post[l])
    return x
```

```cpp
#include <hip/hip_runtime.h>
#include <cstdint>
#include <cstdio>

constexpr int D_MODEL = 2048, BATCH = 4, SEQ = 2048, M_TOK = BATCH * SEQ;
constexpr int HG_HEADS = 8, HG_DIM = 128, HG_W = 1024;
constexpr int ML_HEADS = 4, ML_QK = 128, ML_V = 256, ML_QKW = 512, ML_VW = 1024;
constexpr int CHUNK = 64, NCHUNK = SEQ / CHUNK;
constexpr int D_FF = 5632, IN_W = 11272;
constexpr float EPS = 1e-6f;
constexpr int C_HGQ = 0, C_HGF = 1024, C_HGI = 2048, C_HGG = 3072, C_MQK = 4096, C_MV = 5120, C_MO = 6144, C_IG = 7168, C_FG = 7172, C_GA = 7176, C_GB = 9224;

constexpr size_t MiB = 1u << 20;
constexpr size_t WS_CTL = 0;
constexpr size_t WS_LB = 1 * MiB;
constexpr size_t WS_GATES = 1 * MiB + 65536;
constexpr size_t WS_DEN = 1 * MiB + 65536 + 262144;
constexpr size_t WS_WINT = 2 * MiB;
constexpr size_t WS_HB = 46 * MiB;
constexpr size_t WS_WA = 78 * MiB, WS_WB = 82 * MiB, WS_WOUT = 86 * MiB;
constexpr size_t WS_QH = 94 * MiB;
constexpr size_t WS_LOGF = 110 * MiB;
constexpr size_t WS_VH = 142 * MiB;
constexpr size_t WS_GH = 158 * MiB;
constexpr size_t WS_MQK = 174 * MiB;
constexpr size_t WS_MV = 190 * MiB;
constexpr size_t WS_MO = 206 * MiB;
constexpr size_t WS_GA = 222 * MiB, WS_GB = 254 * MiB;
constexpr size_t WS_YA = 286 * MiB, WS_YB = 302 * MiB;
constexpr size_t WS_FREE = 318 * MiB;
constexpr size_t WS_MQA = 2 * MiB;
constexpr size_t WS_OHG = 34 * MiB;
constexpr size_t WS_NUM = 318 * MiB;
constexpr size_t WS_TMP = 94 * MiB;
constexpr size_t WS_MERGED = 158 * MiB;
constexpr size_t WS_MIX = 2 * MiB;
constexpr size_t WS_H2 = 66 * MiB;
constexpr size_t WS_WG = 98 * MiB, WS_WU = 120 * MiB, WS_WD = 142 * MiB;
constexpr size_t WS_GRAW = 164 * MiB;
constexpr size_t WS_UP = 252 * MiB;
constexpr size_t WS_FFN = 2 * MiB;
constexpr size_t WS_END = 340 * MiB;

typedef unsigned short bf16_t;
__device__ __forceinline__ float bf2f(bf16_t h) { return __uint_as_float(((unsigned)h) << 16); }
__device__ __forceinline__ bf16_t f2bf(float f) { unsigned u = __float_as_uint(f); u += 0x7fffu + ((u >> 16) & 1u); return (bf16_t)(u >> 16); }
__device__ __forceinline__ float sigmoid_f(float x) { return 1.f / (1.f + expf(-x)); }
__device__ __forceinline__ float silu_f(float x) { return x / (1.f + expf(-x)); }
__device__ __forceinline__ float gelu_tanh_f(float x) { const float u = 0.7978845608028654f * (x + 0.044715f * x * x * x); return 0.5f * x * (1.f + tanhf(u)); }
__device__ __forceinline__ float wave_sum(float v) {
#pragma unroll
    for (int o = 1; o < 64; o <<= 1) v += __shfl_xor(v, o);
    return v;
}
namespace gold {
struct Epi { void* out; const float* bias; const float* lb; const void* aux; const void* aux2; int mode; int ldo; float scale; int pad; };
static inline Epi mk(int mode, void* out, int ldo, const float* bias, const float* lb, const void* aux, const void* aux2, float scale) { Epi e{}; e.out = out; e.bias = bias; e.lb = lb; e.aux = aux; e.aux2 = aux2; e.mode = mode; e.ldo = ldo; e.scale = scale; e.pad = 0; return e; }
__device__ __forceinline__ void apply(const Epi& e, int m, int n, float v) {
    const size_t idx = (size_t)m * e.ldo + n;
    const float b = e.bias ? e.bias[n] : 0.f;
    switch (e.mode) {
        case 0: ((bf16_t*)e.out)[idx] = f2bf(v + b); break;
        case 1: ((bf16_t*)e.out)[idx] = f2bf(silu_f(v + b) * e.scale); break;
        case 2: ((bf16_t*)e.out)[idx] = f2bf(sigmoid_f(v + b)); break;
        case 3: { const float l = e.lb[n]; ((float*)e.out)[idx] = logf(l + (1.f - l) * sigmoid_f(v + b)); } break;
        case 4: ((float*)e.out)[idx] = v + b; break;
        case 5: ((float*)e.out)[idx] = bf2f(((const bf16_t*)e.aux)[idx]) * v; break;
        default: ((bf16_t*)e.out)[idx] = f2bf(((const float*)e.aux2)[idx] + bf2f(((const bf16_t*)e.aux)[idx]) * v); break;
    }
}
__device__ __forceinline__ float toF(float v) { return v; }
__device__ __forceinline__ float toF(bf16_t v) { return bf2f(v); }

template <typename AT>
__global__ __launch_bounds__(256) void gemm(const AT* __restrict__ A, int lda, const float* __restrict__ W, int ldw, int K, Epi e) {
    __shared__ float As[16][132];
    __shared__ float Ws[16][132];
    const int tid = threadIdx.x, tx = tid & 15, ty = tid >> 4;
    const int m0 = blockIdx.y * 128, n0 = blockIdx.x * 128;
    float acc[8][8];
#pragma unroll
    for (int i = 0; i < 8; ++i)
#pragma unroll
        for (int j = 0; j < 8; ++j) acc[i][j] = 0.f;
    for (int k0 = 0; k0 < K; k0 += 16) {
        {
            const int r = tid >> 1, ko = (tid & 1) * 8;
            const AT* p = A + (size_t)(m0 + r) * lda + k0 + ko;
#pragma unroll
            for (int i = 0; i < 8; ++i) As[ko + i][r] = toF(p[i]);
        }
        {
            const int k = tid >> 4, c = (tid & 15) * 8;
            const float* p = W + (size_t)(k0 + k) * ldw + n0 + c;
#pragma unroll
            for (int i = 0; i < 8; ++i) Ws[k][c + i] = p[i];
        }
        __syncthreads();
#pragma unroll
        for (int k = 0; k < 16; ++k) {
            float a[8], b[8];
#pragma unroll
            for (int i = 0; i < 4; ++i) { a[i] = As[k][ty * 4 + i]; a[4 + i] = As[k][64 + ty * 4 + i]; b[i] = Ws[k][tx * 4 + i]; b[4 + i] = Ws[k][64 + tx * 4 + i]; }
#pragma unroll
            for (int i = 0; i < 8; ++i)
#pragma unroll
                for (int j = 0; j < 8; ++j) acc[i][j] += a[i] * b[j];
        }
        __syncthreads();
    }
#pragma unroll
    for (int i = 0; i < 8; ++i) {
        const int m = m0 + (i < 4 ? ty * 4 + i : 64 + ty * 4 + (i - 4));
#pragma unroll
        for (int j = 0; j < 8; ++j) { const int n = n0 + (j < 4 ? tx * 4 + j : 64 + tx * 4 + (j - 4)); apply(e, m, n, acc[i][j]); }
    }
}

__global__ void k_lb(const float* __restrict__ logits, float* __restrict__ LB) {
    const int c = blockIdx.x * 256 + threadIdx.x;
    if (c < HG_W) { const float a = logits[c], b = logits[HG_W + c], mx = fmaxf(a, b); const float ea = expf(a - mx), eb = expf(b - mx); LB[c] = ea / (ea + eb); }
}

__global__ __launch_bounds__(256) void k_prep_rows(const float* __restrict__ x, const float* __restrict__ gain, const float* __restrict__ w_in, const float* __restrict__ b_in,
                                                   bf16_t* __restrict__ HB, float* __restrict__ GATES) {
    const int wave = threadIdx.x >> 6, lane = threadIdx.x & 63, row = blockIdx.x * 4 + wave;
    const float4* xr = (const float4*)(x + (size_t)row * D_MODEL);
    float4 v[8]; float ss = 0.f;
#pragma unroll
    for (int j = 0; j < 8; ++j) { v[j] = xr[lane + 64 * j]; ss += v[j].x * v[j].x + v[j].y * v[j].y + v[j].z * v[j].z + v[j].w * v[j].w; }
    ss = wave_sum(ss);
    const float r = 1.f / sqrtf(ss * (1.f / D_MODEL) + EPS);
    float g[8];
#pragma unroll
    for (int q = 0; q < 8; ++q) g[q] = 0.f;
#pragma unroll
    for (int j = 0; j < 8; ++j) {
        const int d0 = (lane + 64 * j) * 4;
        const float4 gn = *(const float4*)(gain + d0);
        const float h0 = v[j].x * r * gn.x, h1 = v[j].y * r * gn.y, h2 = v[j].z * r * gn.z, h3 = v[j].w * r * gn.w;
        ushort4 o; o.x = f2bf(h0); o.y = f2bf(h1); o.z = f2bf(h2); o.w = f2bf(h3);
        *(ushort4*)(HB + (size_t)row * D_MODEL + d0) = o;
        const float hh[4] = {h0, h1, h2, h3};
#pragma unroll
        for (int c = 0; c < 4; ++c) {
            const float* wr = w_in + (size_t)(d0 + c) * IN_W + C_IG;
#pragma unroll
            for (int q = 0; q < 8; ++q) g[q] += hh[c] * wr[q];
        }
    }
#pragma unroll
    for (int q = 0; q < 8; ++q) { g[q] = wave_sum(g[q]); }
    if (lane == 0) {
#pragma unroll
        for (int q = 0; q < 8; ++q) GATES[(size_t)row * 8 + q] = g[q] + b_in[C_IG + q];
    }
}

__global__ void k_mlconv(const bf16_t* __restrict__ MQK, const float* __restrict__ cw, const float* __restrict__ cb, float* __restrict__ MQA) {
    const size_t i = (size_t)blockIdx.x * 256 + threadIdx.x;
    const int c = (int)(i & 1023); const int row = (int)(i >> 10); const int t = row % SEQ;
    float a = cb[c];
#pragma unroll
    for (int j = 0; j < 4; ++j) { const int tt = t - 3 + j; if (tt >= 0) a += cw[j * 1024 + c] * bf2f(MQK[(size_t)(row - 3 + j) * 1024 + c]); }
    MQA[i] = silu_f(a);
}

__global__ __launch_bounds__(64) void k_hgscan(const bf16_t* __restrict__ QH, const float* __restrict__ LOGF, const bf16_t* __restrict__ VH, float* __restrict__ O) {
    __shared__ float sq[32][128];
    __shared__ float sf[32][128];
    __shared__ float sv[32][32];
    const int bh = blockIdx.x >> 2, sl = blockIdx.x & 3, b = bh >> 3, h = bh & 7, lane = threadIdx.x, e = lane & 31, dh = lane >> 5;
    float S[64];
#pragma unroll
    for (int i = 0; i < 64; ++i) S[i] = 0.f;
    for (int t0 = 0; t0 < SEQ; t0 += 32) {
        for (int i = lane; i < 32 * 128; i += 64) { const int tt = i >> 7, d = i & 127; const size_t g = (size_t)(b * SEQ + t0 + tt) * 1024 + h * 128 + d; sq[tt][d] = bf2f(QH[g]); sf[tt][d] = expf(LOGF[g]); }
        for (int i = lane; i < 32 * 32; i += 64) { const int tt = i >> 5, ee = i & 31; sv[tt][ee] = bf2f(VH[(size_t)(b * SEQ + t0 + tt) * 1024 + h * 128 + sl * 32 + ee]); }
        __syncthreads();
        for (int tt = 0; tt < 32; ++tt) {
            const float v = sv[tt][e]; float o = 0.f;
#pragma unroll
            for (int dd = 0; dd < 64; ++dd) { const float f = sf[tt][dh * 64 + dd]; S[dd] = f * S[dd] + (1.f - f) * v; o += S[dd] * sq[tt][dh * 64 + dd]; }
            o += __shfl_xor(o, 32);
            if (lane < 32) O[(size_t)(b * SEQ + t0 + tt) * 1024 + h * 128 + sl * 32 + e] = o;
        }
        __syncthreads();
    }
}
__global__ __launch_bounds__(256) void k_hgfin(const float* __restrict__ O, const bf16_t* __restrict__ GH, const float* __restrict__ gain, bf16_t* __restrict__ YA) {
    const int gw = (blockIdx.x * 256 + threadIdx.x) >> 6, lane = threadIdx.x & 63;
    const size_t base = (size_t)gw * 128; const int col = (gw & 7) * 128;
    const float a = O[base + lane], c = O[base + 64 + lane];
    const float ss = wave_sum(a * a + c * c);
    const float r = 1.f / sqrtf(ss * (1.f / 128.f) + EPS);
    YA[base + lane] = f2bf(a * r * gain[col + lane] * bf2f(GH[base + lane]));
    YA[base + 64 + lane] = f2bf(c * r * gain[col + 64 + lane] * bf2f(GH[base + 64 + lane]));
}

__global__ __launch_bounds__(64) void k_mlscan(const float* __restrict__ MQA, const bf16_t* __restrict__ MV, const float* __restrict__ GATES, float* __restrict__ NUM, float* __restrict__ DEN) {
    __shared__ float sq[32][128];
    __shared__ float sk[32][128];
    __shared__ float sv[32][32];
    __shared__ float sfg[32];
    const int bh = blockIdx.x / 9, sl = blockIdx.x % 9, b = bh >> 2, h = bh & 3, lane = threadIdx.x, e = lane & 31, dh = lane >> 5;
    const float kscale = 0.08838834764831845f;
    float C[64];
#pragma unroll
    for (int i = 0; i < 64; ++i) C[i] = 0.f;
    for (int t0 = 0; t0 < SEQ; t0 += 32) {
        for (int i = lane; i < 32 * 128; i += 64) {
            const int tt = i >> 7, d = i & 127; const size_t row = (size_t)(b * SEQ + t0 + tt);
            const float ig = GATES[row * 8 + h];
            sq[tt][d] = MQA[row * 1024 + h * 128 + d];
            sk[tt][d] = MQA[row * 1024 + 512 + h * 128 + d] * kscale * expf(ig);
        }
        for (int i = lane; i < 32 * 32; i += 64) { const int tt = i >> 5, ee = i & 31; const size_t row = (size_t)(b * SEQ + t0 + tt);
            sv[tt][ee] = (sl < 8) ? bf2f(MV[row * 1024 + h * 256 + sl * 32 + ee]) : (ee == 0 ? 1.f : 0.f); }
        if (lane < 32) sfg[lane] = sigmoid_f(GATES[(size_t)(b * SEQ + t0 + lane) * 8 + 4 + h]);
        __syncthreads();
        for (int tt = 0; tt < 32; ++tt) {
            const float v = sv[tt][e], f = sfg[tt]; float o = 0.f;
#pragma unroll
            for (int dd = 0; dd < 64; ++dd) { C[dd] = f * C[dd] + sk[tt][dh * 64 + dd] * v; o += C[dd] * sq[tt][dh * 64 + dd]; }
            o += __shfl_xor(o, 32);
            const size_t row = (size_t)(b * SEQ + t0 + tt);
            if (lane < 32) { if (sl < 8) NUM[row * 1024 + h * 256 + sl * 32 + e] = o; else if (e == 0) DEN[row * 4 + h] = o; }
        }
        __syncthreads();
    }
}
__global__ __launch_bounds__(256) void k_mlfin(const float* __restrict__ NUM, const float* __restrict__ DEN, const bf16_t* __restrict__ MO, const float* __restrict__ gain, bf16_t* __restrict__ YB) {
    const int gw = (blockIdx.x * 256 + threadIdx.x) >> 6, lane = threadIdx.x & 63;
    const size_t base = (size_t)gw * 256; const int col = (gw & 3) * 256;
    const float dn = 1.f / fmaxf(fabsf(DEN[gw]), 1.f);
    float hv[4]; float ss = 0.f;
#pragma unroll
    for (int j = 0; j < 4; ++j) { hv[j] = NUM[base + lane + 64 * j] * dn; ss += hv[j] * hv[j]; }
    ss = wave_sum(ss);
    const float r = 1.f / sqrtf(ss * (1.f / 256.f) + EPS);
#pragma unroll
    for (int j = 0; j < 4; ++j) YB[base + lane + 64 * j] = f2bf(bf2f(MO[base + lane + 64 * j]) * hv[j] * r * gain[col + lane + 64 * j]);
}

__global__ __launch_bounds__(256) void k_stageF(const float* __restrict__ x, const float* __restrict__ MIX, const float* __restrict__ g_post, const float* __restrict__ g_pre2,
                                                float* __restrict__ X1, bf16_t* __restrict__ H2) {
    const int wave = threadIdx.x >> 6, lane = threadIdx.x & 63, row = blockIdx.x * 4 + wave;
    const float4* mr = (const float4*)(MIX + (size_t)row * D_MODEL); const float4* xr = (const float4*)(x + (size_t)row * D_MODEL);
    float4 v[8]; float ss = 0.f;
#pragma unroll
    for (int j = 0; j < 8; ++j) { v[j] = mr[lane + 64 * j]; ss += v[j].x * v[j].x + v[j].y * v[j].y + v[j].z * v[j].z + v[j].w * v[j].w; }
    ss = wave_sum(ss);
    const float r = 1.f / sqrtf(ss * (1.f / D_MODEL) + EPS);
    float s2 = 0.f;
#pragma unroll
    for (int j = 0; j < 8; ++j) {
        const float4 gp = *(const float4*)(g_post + (lane + 64 * j) * 4); const float4 xv = xr[lane + 64 * j];
        v[j].x = xv.x + v[j].x * r * gp.x; v[j].y = xv.y + v[j].y * r * gp.y; v[j].z = xv.z + v[j].z * r * gp.z; v[j].w = xv.w + v[j].w * r * gp.w;
        s2 += v[j].x * v[j].x + v[j].y * v[j].y + v[j].z * v[j].z + v[j].w * v[j].w;
        ((float4*)(X1 + (size_t)row * D_MODEL))[lane + 64 * j] = v[j];
    }
    s2 = wave_sum(s2);
    const float r2 = 1.f / sqrtf(s2 * (1.f / D_MODEL) + EPS);
#pragma unroll
    for (int j = 0; j < 8; ++j) {
        const float4 g2 = *(const float4*)(g_pre2 + (lane + 64 * j) * 4);
        ushort4 o; o.x = f2bf(v[j].x * r2 * g2.x); o.y = f2bf(v[j].y * r2 * g2.y); o.z = f2bf(v[j].z * r2 * g2.z); o.w = f2bf(v[j].w * r2 * g2.w);
        *(ushort4*)(H2 + (size_t)row * D_MODEL + (lane + 64 * j) * 4) = o;
    }
}
__global__ void k_stageH(const bf16_t* __restrict__ GRAW, bf16_t* UPACT, const float* __restrict__ cw, const float* __restrict__ cb) {
    const size_t i = (size_t)blockIdx.x * 256 + threadIdx.x;
    const int c = (int)(i % D_FF); const int row = (int)(i / D_FF); const int t = row % SEQ;
    float a = cb[c];
#pragma unroll
    for (int j = 0; j < 3; ++j) { const int tt = t - 2 + j; if (tt >= 0) a += cw[j * D_FF + c] * bf2f(GRAW[(size_t)(row - 2 + j) * D_FF + c]); }
    UPACT[i] = f2bf(gelu_tanh_f(a) * bf2f(UPACT[i]));
}
__global__ __launch_bounds__(256) void k_stageJ(const float* __restrict__ FFN, const float* __restrict__ g_post, float* OUT) {
    const int wave = threadIdx.x >> 6, lane = threadIdx.x & 63, row = blockIdx.x * 4 + wave;
    const float4* fr = (const float4*)(FFN + (size_t)row * D_MODEL); float4* orow = (float4*)(OUT + (size_t)row * D_MODEL);
    float4 v[8]; float ss = 0.f;
#pragma unroll
    for (int j = 0; j < 8; ++j) { v[j] = fr[lane + 64 * j]; ss += v[j].x * v[j].x + v[j].y * v[j].y + v[j].z * v[j].z + v[j].w * v[j].w; }
    ss = wave_sum(ss);
    const float r = 1.f / sqrtf(ss * (1.f / D_MODEL) + EPS);
#pragma unroll
    for (int j = 0; j < 8; ++j) {
        const float4 gp = *(const float4*)(g_post + (lane + 64 * j) * 4); float4 xv = orow[lane + 64 * j];
        xv.x += v[j].x * r * gp.x; xv.y += v[j].y * r * gp.y; xv.z += v[j].z * r * gp.z; xv.w += v[j].w * r * gp.w;
        orow[lane + 64 * j] = xv;
    }
}
}
struct Ptrs {
    const float *x, *g_mix_pre, *g_mix_post, *g_ffn_pre, *g_ffn_post, *w_in, *b_in, *lb_logits, *hg_norm, *ml_conv_w, *ml_conv_b, *ml_norm, *w_up_a, *w_up_b, *w_out, *ffn_w_gate, *ffn_w_up,
        *ffn_conv_w, *ffn_conv_b, *ffn_w_down;
    float* out; unsigned char* ws;
};
static Ptrs make_ptrs(void* const* d_in, void* d_out, void* d_ws) {
    Ptrs p;
    p.x = (const float*)d_in[0]; p.g_mix_pre = (const float*)d_in[1]; p.g_mix_post = (const float*)d_in[2]; p.g_ffn_pre = (const float*)d_in[3]; p.g_ffn_post = (const float*)d_in[4];
    p.w_in = (const float*)d_in[5]; p.b_in = (const float*)d_in[6]; p.lb_logits = (const float*)d_in[7]; p.hg_norm = (const float*)d_in[8]; p.ml_conv_w = (const float*)d_in[9];
    p.ml_conv_b = (const float*)d_in[10]; p.ml_norm = (const float*)d_in[11]; p.w_up_a = (const float*)d_in[12]; p.w_up_b = (const float*)d_in[13]; p.w_out = (const float*)d_in[14];
    p.ffn_w_gate = (const float*)d_in[15]; p.ffn_w_up = (const float*)d_in[16]; p.ffn_conv_w = (const float*)d_in[17]; p.ffn_conv_b = (const float*)d_in[18]; p.ffn_w_down = (const float*)d_in[19];
    p.out = (float*)d_out; p.ws = (unsigned char*)d_ws;
    return p;
}
#define WSP(T, off) ((T*)(p.ws + (off)))

static void gold_stageA(const Ptrs& p, hipStream_t s) {
    gold::k_lb<<<4, 256, 0, s>>>(p.lb_logits, WSP(float, WS_LB));
    gold::k_prep_rows<<<M_TOK / 4, 256, 0, s>>>(p.x, p.g_mix_pre, p.w_in, p.b_in, WSP(bf16_t, WS_HB), WSP(float, WS_GATES));
}
static void gold_stageB(const Ptrs& p, hipStream_t s) {
    auto seg = [&](int col, int n, gold::Epi e) { e.bias = p.b_in + col; gold::gemm<bf16_t><<<dim3(n / 128, M_TOK / 128), 256, 0, s>>>(WSP(bf16_t, WS_HB), D_MODEL, p.w_in + col, IN_W, D_MODEL, e); };
    const float qs = 0.08838834764831845f;
    seg(C_HGQ, 1024, gold::mk(1, WSP(void, WS_QH), 1024, nullptr, nullptr, nullptr, nullptr, qs));
    seg(C_HGF, 1024, gold::mk(3, WSP(void, WS_LOGF), 1024, nullptr, WSP(float, WS_LB), nullptr, nullptr, 1.f));
    seg(C_HGI, 1024, gold::mk(0, WSP(void, WS_VH), 1024, nullptr, nullptr, nullptr, nullptr, 1.f));
    seg(C_HGG, 1024, gold::mk(1, WSP(void, WS_GH), 1024, nullptr, nullptr, nullptr, nullptr, 1.f));
    seg(C_MQK, 1024, gold::mk(0, WSP(void, WS_MQK), 1024, nullptr, nullptr, nullptr, nullptr, 1.f));
    seg(C_MV, 1024, gold::mk(0, WSP(void, WS_MV), 1024, nullptr, nullptr, nullptr, nullptr, 1.f));
    seg(C_MO, 1024, gold::mk(2, WSP(void, WS_MO), 1024, nullptr, nullptr, nullptr, nullptr, 1.f));
    seg(C_GA, 2048, gold::mk(2, WSP(void, WS_GA), 2048, nullptr, nullptr, nullptr, nullptr, 1.f));
    seg(C_GB, 2048, gold::mk(2, WSP(void, WS_GB), 2048, nullptr, nullptr, nullptr, nullptr, 1.f));
}
static void gold_stageC(const Ptrs& p, hipStream_t s) {
    gold::k_mlconv<<<M_TOK * 1024 / 256, 256, 0, s>>>(WSP(bf16_t, WS_MQK), p.ml_conv_w, p.ml_conv_b, WSP(float, WS_MQA));
    gold::k_hgscan<<<BATCH * HG_HEADS * 4, 64, 0, s>>>(WSP(bf16_t, WS_QH), WSP(float, WS_LOGF), WSP(bf16_t, WS_VH), WSP(float, WS_OHG));
    gold::k_hgfin<<<M_TOK * 8 / 4, 256, 0, s>>>(WSP(float, WS_OHG), WSP(bf16_t, WS_GH), p.hg_norm, WSP(bf16_t, WS_YA));
    gold::k_mlscan<<<BATCH * ML_HEADS * 9, 64, 0, s>>>(WSP(float, WS_MQA), WSP(bf16_t, WS_MV), WSP(float, WS_GATES), WSP(float, WS_NUM), WSP(float, WS_DEN));
    gold::k_mlfin<<<M_TOK * 4 / 4, 256, 0, s>>>(WSP(float, WS_NUM), WSP(float, WS_DEN), WSP(bf16_t, WS_MO), p.ml_norm, WSP(bf16_t, WS_YB));
}
static void gold_stageD(const Ptrs& p, hipStream_t s) {
    gold::gemm<bf16_t><<<dim3(2048 / 128, M_TOK / 128), 256, 0, s>>>(WSP(bf16_t, WS_YA), 1024, p.w_up_a, 2048, 1024, gold::mk(5, WSP(void, WS_TMP), 2048, nullptr, nullptr, WSP(void, WS_GA), nullptr, 1.f));
    gold::gemm<bf16_t><<<dim3(2048 / 128, M_TOK / 128), 256, 0, s>>>(WSP(bf16_t, WS_YB), 1024, p.w_up_b, 2048, 1024, gold::mk(6, WSP(void, WS_MERGED), 2048, nullptr, nullptr, WSP(void, WS_GB), WSP(void, WS_TMP), 1.f));
}
static void gold_stageE(const Ptrs& p, hipStream_t s) {
    gold::gemm<bf16_t><<<dim3(2048 / 128, M_TOK / 128), 256, 0, s>>>(WSP(bf16_t, WS_MERGED), 2048, p.w_out, 2048, 2048, gold::mk(4, WSP(void, WS_MIX), 2048, nullptr, nullptr, nullptr, nullptr, 1.f));
}
static void gold_stageF(const Ptrs& p, hipStream_t s) {
    gold::k_stageF<<<M_TOK / 4, 256, 0, s>>>(p.x, WSP(float, WS_MIX), p.g_mix_post, p.g_ffn_pre, p.out, WSP(bf16_t, WS_H2));
}
static void gold_stageG(const Ptrs& p, hipStream_t s) {
    gold::gemm<bf16_t><<<dim3(D_FF / 128, M_TOK / 128), 256, 0, s>>>(WSP(bf16_t, WS_H2), 2048, p.ffn_w_gate, D_FF, 2048, gold::mk(0, WSP(void, WS_GRAW), D_FF, nullptr, nullptr, nullptr, nullptr, 1.f));
    gold::gemm<bf16_t><<<dim3(D_FF / 128, M_TOK / 128), 256, 0, s>>>(WSP(bf16_t, WS_H2), 2048, p.ffn_w_up, D_FF, 2048, gold::mk(0, WSP(void, WS_UP), D_FF, nullptr, nullptr, nullptr, nullptr, 1.f));
}
static void gold_stageH(const Ptrs& p, hipStream_t s) {
    gold::k_stageH<<<(unsigned)((size_t)M_TOK * D_FF / 256), 256, 0, s>>>(WSP(bf16_t, WS_GRAW), WSP(bf16_t, WS_UP), p.ffn_conv_w, p.ffn_conv_b);
}
static void gold_stageI(const Ptrs& p, hipStream_t s) {
    gold::gemm<bf16_t><<<dim3(2048 / 128, M_TOK / 128), 256, 0, s>>>(WSP(bf16_t, WS_UP), D_FF, p.ffn_w_down, 2048, D_FF, gold::mk(4, WSP(void, WS_FFN), 2048, nullptr, nullptr, nullptr, nullptr, 1.f));
}
static void gold_stageJ(const Ptrs& p, hipStream_t s) {
    gold::k_stageJ<<<M_TOK / 4, 256, 0, s>>>(WSP(float, WS_FFN), p.g_ffn_post, p.out);
}
extern "C" void kernel_launch(void* const* d_in, const int* in_sizes, int n_in, void* d_out, int out_size, void* d_ws, size_t ws_size, hipStream_t stream) {
    if (n_in != 20 || out_size != M_TOK * D_MODEL || ws_size < WS_END) { fprintf(stderr, "kernel_launch: unexpected shapes n_in %d out %d ws %zu\n", n_in, out_size, ws_size); return; }
    const Ptrs p = make_ptrs(d_in, d_out, d_ws);
    gold_stageA(p, stream); gold_stageB(p, stream); gold_stageC(p, stream); gold_stageD(p, stream); gold_stageE(p, stream);
    gold_stageF(p, stream); gold_stageG(p, stream); gold_stageH(p, stream); gold_stageI(p, stream); gold_stageJ(p, stream);
}
```

```cpp
#include <hip/hip_runtime.h>
#include <cstdint>
#include <cstdio>

constexpr int D_MODEL = 2048, BATCH = 4, SEQ = 2048, M_TOK = BATCH * SEQ;
constexpr int HG_HEADS = 8, HG_DIM = 128, HG_W = 1024;
constexpr int ML_HEADS = 4, ML_QK = 128, ML_V = 256, ML_QKW = 512, ML_VW = 1024;
constexpr int CHUNK = 64, NCHUNK = SEQ / CHUNK;
constexpr int D_FF = 5632, IN_W = 11272;
constexpr float EPS = 1e-6f;
constexpr int C_HGQ = 0, C_HGF = 1024, C_HGI = 2048, C_HGG = 3072, C_MQK = 4096, C_MV = 5120, C_MO = 6144, C_IG = 7168, C_FG = 7172, C_GA = 7176, C_GB = 9224;

constexpr size_t MiB = 1u << 20;
constexpr size_t WS_CTL = 0;
constexpr size_t WS_LB = 1 * MiB;
constexpr size_t WS_GATES = 1 * MiB + 65536;
constexpr size_t WS_DEN = 1 * MiB + 65536 + 262144;
constexpr size_t WS_WINT = 2 * MiB;
constexpr size_t WS_HB = 46 * MiB;
constexpr size_t WS_WA = 78 * MiB, WS_WB = 82 * MiB, WS_WOUT = 86 * MiB;
constexpr size_t WS_QH = 94 * MiB;
constexpr size_t WS_LOGF = 110 * MiB;
constexpr size_t WS_VH = 142 * MiB;
constexpr size_t WS_GH = 158 * MiB;
constexpr size_t WS_MQK = 174 * MiB;
constexpr size_t WS_MV = 190 * MiB;
constexpr size_t WS_MO = 206 * MiB;
constexpr size_t WS_GA = 222 * MiB, WS_GB = 254 * MiB;
constexpr size_t WS_YA = 286 * MiB, WS_YB = 302 * MiB;
constexpr size_t WS_FREE = 318 * MiB;
constexpr size_t WS_MQA = 2 * MiB;
constexpr size_t WS_OHG = 34 * MiB;
constexpr size_t WS_NUM = 318 * MiB;
constexpr size_t WS_TMP = 94 * MiB;
constexpr size_t WS_MERGED = 158 * MiB;
constexpr size_t WS_MIX = 2 * MiB;
constexpr size_t WS_H2 = 66 * MiB;
constexpr size_t WS_WG = 98 * MiB, WS_WU = 120 * MiB, WS_WD = 142 * MiB;
constexpr size_t WS_GRAW = 164 * MiB;
constexpr size_t WS_UP = 252 * MiB;
constexpr size_t WS_FFN = 2 * MiB;
constexpr size_t WS_END = 340 * MiB;

typedef unsigned short bf16_t;
__device__ __forceinline__ float bf2f(bf16_t h) { return __uint_as_float(((unsigned)h) << 16); }
__device__ __forceinline__ bf16_t f2bf(float f) { unsigned u = __float_as_uint(f); u += 0x7fffu + ((u >> 16) & 1u); return (bf16_t)(u >> 16); }
__device__ __forceinline__ float sigmoid_f(float x) { return 1.f / (1.f + expf(-x)); }
__device__ __forceinline__ float silu_f(float x) { return x / (1.f + expf(-x)); }
__device__ __forceinline__ float gelu_tanh_f(float x) { const float u = 0.7978845608028654f * (x + 0.044715f * x * x * x); return 0.5f * x * (1.f + tanhf(u)); }
__device__ __forceinline__ float wave_sum(float v) {
#pragma unroll
    for (int o = 1; o < 64; o <<= 1) v += __shfl_xor(v, o);
    return v;
}
namespace gold {
struct Epi { void* out; const float* bias; const float* lb; const void* aux; const void* aux2; int mode; int ldo; float scale; int pad; };
static inline Epi mk(int mode, void* out, int ldo, const float* bias, const float* lb, const void* aux, const void* aux2, float scale) { Epi e{}; e.out = out; e.bias = bias; e.lb = lb; e.aux = aux; e.aux2 = aux2; e.mode = mode; e.ldo = ldo; e.scale = scale; e.pad = 0; return e; }
__device__ __forceinline__ void apply(const Epi& e, int m, int n, float v) {
    const size_t idx = (size_t)m * e.ldo + n;
    const float b = e.bias ? e.bias[n] : 0.f;
    switch (e.mode) {
        case 0: ((bf16_t*)e.out)[idx] = f2bf(v + b); break;
        case 1: ((bf16_t*)e.out)[idx] = f2bf(silu_f(v + b) * e.scale); break;
        case 2: ((bf16_t*)e.out)[idx] = f2bf(sigmoid_f(v + b)); break;
        case 3: { const float l = e.lb[n]; ((float*)e.out)[idx] = logf(l + (1.f - l) * sigmoid_f(v + b)); } break;
        case 4: ((float*)e.out)[idx] = v + b; break;
        case 5: ((float*)e.out)[idx] = bf2f(((const bf16_t*)e.aux)[idx]) * v; break;
        default: ((bf16_t*)e.out)[idx] = f2bf(((const float*)e.aux2)[idx] + bf2f(((const bf16_t*)e.aux)[idx]) * v); break;
    }
}
__device__ __forceinline__ float toF(float v) { return v; }
__device__ __forceinline__ float toF(bf16_t v) { return bf2f(v); }

template <typename AT>
__global__ __launch_bounds__(256) void gemm(const AT* __restrict__ A, int lda, const float* __restrict__ W, int ldw, int K, Epi e) {
    __shared__ float As[16][132];
    __shared__ float Ws[16][132];
    const int tid = threadIdx.x, tx = tid & 15, ty = tid >> 4;
    const int m0 = blockIdx.y * 128, n0 = blockIdx.x * 128;
    float acc[8][8];
#pragma unroll
    for (int i = 0; i < 8; ++i)
#pragma unroll
        for (int j = 0; j < 8; ++j) acc[i][j] = 0.f;
    for (int k0 = 0; k0 < K; k0 += 16) {
        {
            const int r = tid >> 1, ko = (tid & 1) * 8;
            const AT* p = A + (size_t)(m0 + r) * lda + k0 + ko;
#pragma unroll
            for (int i = 0; i < 8; ++i) As[ko + i][r] = toF(p[i]);
        }
        {
            const int k = tid >> 4, c = (tid & 15) * 8;
            const float* p = W + (size_t)(k0 + k) * ldw + n0 + c;
#pragma unroll
            for (int i = 0; i < 8; ++i) Ws[k][c + i] = p[i];
        }
        __syncthreads();
#pragma unroll
        for (int k = 0; k < 16; ++k) {
            float a[8], b[8];
#pragma unroll
            for (int i = 0; i < 4; ++i) { a[i] = As[k][ty * 4 + i]; a[4 + i] = As[k][64 + ty * 4 + i]; b[i] = Ws[k][tx * 4 + i]; b[4 + i] = Ws[k][64 + tx * 4 + i]; }
#pragma unroll
            for (int i = 0; i < 8; ++i)
#pragma unroll
                for (int j = 0; j < 8; ++j) acc[i][j] += a[i] * b[j];
        }
        __syncthreads();
    }
#pragma unroll
    for (int i = 0; i < 8; ++i) {
        const int m = m0 + (i < 4 ? ty * 4 + i : 64 + ty * 4 + (i - 4));
#pragma unroll
        for (int j = 0; j < 8; ++j) { const int n = n0 + (j < 4 ? tx * 4 + j : 64 + tx * 4 + (j - 4)); apply(e, m, n, acc[i][j]); }
    }
}

__global__ void k_lb(const float* __restrict__ logits, float* __restrict__ LB) {
    const int c = blockIdx.x * 256 + threadIdx.x;
    if (c < HG_W) { const float a = logits[c], b = logits[HG_W + c], mx = fmaxf(a, b); const float ea = expf(a - mx), eb = expf(b - mx); LB[c] = ea / (ea + eb); }
}

__global__ __launch_bounds__(256) void k_prep_rows(const float* __restrict__ x, const float* __restrict__ gain, const float* __restrict__ w_in, const float* __restrict__ b_in,
                                                   bf16_t* __restrict__ HB, float* __restrict__ GATES) {
    const int wave = threadIdx.x >> 6, lane = threadIdx.x & 63, row = blockIdx.x * 4 + wave;
    const float4* xr = (const float4*)(x + (size_t)row * D_MODEL);
    float4 v[8]; float ss = 0.f;
#pragma unroll
    for (int j = 0; j < 8; ++j) { v[j] = xr[lane + 64 * j]; ss += v[j].x * v[j].x + v[j].y * v[j].y + v[j].z * v[j].z + v[j].w * v[j].w; }
    ss = wave_sum(ss);
    const float r = 1.f / sqrtf(ss * (1.f / D_MODEL) + EPS);
    float g[8];
#pragma unroll
    for (int q = 0; q < 8; ++q) g[q] = 0.f;
#pragma unroll
    for (int j = 0; j < 8; ++j) {
        const int d0 = (lane + 64 * j) * 4;
        const float4 gn = *(const float4*)(gain + d0);
        const float h0 = v[j].x * r * gn.x, h1 = v[j].y * r * gn.y, h2 = v[j].z * r * gn.z, h3 = v[j].w * r * gn.w;
        ushort4 o; o.x = f2bf(h0); o.y = f2bf(h1); o.z = f2bf(h2); o.w = f2bf(h3);
        *(ushort4*)(HB + (size_t)row * D_MODEL + d0) = o;
        const float hh[4] = {h0, h1, h2, h3};
#pragma unroll
        for (int c = 0; c < 4; ++c) {
            const float* wr = w_in + (size_t)(d0 + c) * IN_W + C_IG;
#pragma unroll
            for (int q = 0; q < 8; ++q) g[q] += hh[c] * wr[q];
        }
    }
#pragma unroll
    for (int q = 0; q < 8; ++q) { g[q] = wave_sum(g[q]); }
    if (lane == 0) {
#pragma unroll
        for (int q = 0; q < 8; ++q) GATES[(size_t)row * 8 + q] = g[q] + b_in[C_IG + q];
    }
}

__global__ void k_mlconv(const bf16_t* __restrict__ MQK, const float* __restrict__ cw, const float* __restrict__ cb, float* __restrict__ MQA) {
    const size_t i = (size_t)blockIdx.x * 256 + threadIdx.x;
    const int c = (int)(i & 1023); const int row = (int)(i >> 10); const int t = row % SEQ;
    float a = cb[c];
#pragma unroll
    for (int j = 0; j < 4; ++j) { const int tt = t - 3 + j; if (tt >= 0) a += cw[j * 1024 + c] * bf2f(MQK[(size_t)(row - 3 + j) * 1024 + c]); }
    MQA[i] = silu_f(a);
}

__global__ __launch_bounds__(64) void k_hgscan(const bf16_t* __restrict__ QH, const float* __restrict__ LOGF, const bf16_t* __restrict__ VH, float* __restrict__ O) {
    __shared__ float sq[32][128];
    __shared__ float sf[32][128];
    __shared__ float sv[32][32];
    const int bh = blockIdx.x >> 2, sl = blockIdx.x & 3, b = bh >> 3, h = bh & 7, lane = threadIdx.x, e = lane & 31, dh = lane >> 5;
    float S[64];
#pragma unroll
    for (int i = 0; i < 64; ++i) S[i] = 0.f;
    for (int t0 = 0; t0 < SEQ; t0 += 32) {
        for (int i = lane; i < 32 * 128; i += 64) { const int tt = i >> 7, d = i & 127; const size_t g = (size_t)(b * SEQ + t0 + tt) * 1024 + h * 128 + d; sq[tt][d] = bf2f(QH[g]); sf[tt][d] = expf(LOGF[g]); }
        for (int i = lane; i < 32 * 32; i += 64) { const int tt = i >> 5, ee = i & 31; sv[tt][ee] = bf2f(VH[(size_t)(b * SEQ + t0 + tt) * 1024 + h * 128 + sl * 32 + ee]); }
        __syncthreads();
        for (int tt = 0; tt < 32; ++tt) {
            const float v = sv[tt][e]; float o = 0.f;
#pragma unroll
            for (int dd = 0; dd < 64; ++dd) { const float f = sf[tt][dh * 64 + dd]; S[dd] = f * S[dd] + (1.f - f) * v; o += S[dd] * sq[tt][dh * 64 + dd]; }
            o += __shfl_xor(o, 32);
            if (lane < 32) O[(size_t)(b * SEQ + t0 + tt) * 1024 + h * 128 + sl * 32 + e] = o;
        }
        __syncthreads();
    }
}
__global__ __launch_bounds__(256) void k_hgfin(const float* __restrict__ O, const bf16_t* __restrict__ GH, const float* __restrict__ gain, bf16_t* __restrict__ YA) {
    const int gw = (blockIdx.x * 256 + threadIdx.x) >> 6, lane = threadIdx.x & 63;
    const size_t base = (size_t)gw * 128; const int col = (gw & 7) * 128;
    const float a = O[base + lane], c = O[base + 64 + lane];
    const float ss = wave_sum(a * a + c * c);
    const float r = 1.f / sqrtf(ss * (1.f / 128.f) + EPS);
    YA[base + lane] = f2bf(a * r * gain[col + lane] * bf2f(GH[base + lane]));
    YA[base + 64 + lane] = f2bf(c * r * gain[col + 64 + lane] * bf2f(GH[base + 64 + lane]));
}

__global__ __launch_bounds__(64) void k_mlscan(const float* __restrict__ MQA, const bf16_t* __restrict__ MV, const float* __restrict__ GATES, float* __restrict__ NUM, float* __restrict__ DEN) {
    __shared__ float sq[32][128];
    __shared__ float sk[32][128];
    __shared__ float sv[32][32];
    __shared__ float sfg[32];
    const int bh = blockIdx.x / 9, sl = blockIdx.x % 9, b = bh >> 2, h = bh & 3, lane = threadIdx.x, e = lane & 31, dh = lane >> 5;
    const float kscale = 0.08838834764831845f;
    float C[64];
#pragma unroll
    for (int i = 0; i < 64; ++i) C[i] = 0.f;
    for (int t0 = 0; t0 < SEQ; t0 += 32) {
        for (int i = lane; i < 32 * 128; i += 64) {
            const int tt = i >> 7, d = i & 127; const size_t row = (size_t)(b * SEQ + t0 + tt);
            const float ig = GATES[row * 8 + h];
            sq[tt][d] = MQA[row * 1024 + h * 128 + d];
            sk[tt][d] = MQA[row * 1024 + 512 + h * 128 + d] * kscale * expf(ig);
        }
        for (int i = lane; i < 32 * 32; i += 64) { const int tt = i >> 5, ee = i & 31; const size_t row = (size_t)(b * SEQ + t0 + tt);
            sv[tt][ee] = (sl < 8) ? bf2f(MV[row * 1024 + h * 256 + sl * 32 + ee]) : (ee == 0 ? 1.f : 0.f); }
        if (lane < 32) sfg[lane] = sigmoid_f(GATES[(size_t)(b * SEQ + t0 + lane) * 8 + 4 + h]);
        __syncthreads();
        for (int tt = 0; tt < 32; ++tt) {
            const float v = sv[tt][e], f = sfg[tt]; float o = 0.f;
#pragma unroll
            for (int dd = 0; dd < 64; ++dd) { C[dd] = f * C[dd] + sk[tt][dh * 64 + dd] * v; o += C[dd] * sq[tt][dh * 64 + dd]; }
            o += __shfl_xor(o, 32);
            const size_t row = (size_t)(b * SEQ + t0 + tt);
            if (lane < 32) { if (sl < 8) NUM[row * 1024 + h * 256 + sl * 32 + e] = o; else if (e == 0) DEN[row * 4 + h] = o; }
        }
        __syncthreads();
    }
}
__global__ __launch_bounds__(256) void k_mlfin(const float* __restrict__ NUM, const float* __restrict__ DEN, const bf16_t* __restrict__ MO, const float* __restrict__ gain, bf16_t* __restrict__ YB) {
    const int gw = (blockIdx.x * 256 + threadIdx.x) >> 6, lane = threadIdx.x & 63;
    const size_t base = (size_t)gw * 256; const int col = (gw & 3) * 256;
    const float dn = 1.f / fmaxf(fabsf(DEN[gw]), 1.f);
    float hv[4]; float ss = 0.f;
#pragma unroll
    for (int j = 0; j < 4; ++j) { hv[j] = NUM[base + lane + 64 * j] * dn; ss += hv[j] * hv[j]; }
    ss = wave_sum(ss);
    const float r = 1.f / sqrtf(ss * (1.f / 256.f) + EPS);
#pragma unroll
    for (int j = 0; j < 4; ++j) YB[base + lane + 64 * j] = f2bf(bf2f(MO[base + lane + 64 * j]) * hv[j] * r * gain[col + lane + 64 * j]);
}

__global__ __launch_bounds__(256) void k_stageF(const float* __restrict__ x, const float* __restrict__ MIX, const float* __restrict__ g_post, const float* __restrict__ g_pre2,
                                                float* __restrict__ X1, bf16_t* __restrict__ H2) {
    const int wave = threadIdx.x >> 6, lane = threadIdx.x & 63, row = blockIdx.x * 4 + wave;
    const float4* mr = (const float4*)(MIX + (size_t)row * D_MODEL); const float4* xr = (const float4*)(x + (size_t)row * D_MODEL);
    float4 v[8]; float ss = 0.f;
#pragma unroll
    for (int j = 0; j < 8; ++j) { v[j] = mr[lane + 64 * j]; ss += v[j].x * v[j].x + v[j].y * v[j].y + v[j].z * v[j].z + v[j].w * v[j].w; }
    ss = wave_sum(ss);
    const float r = 1.f / sqrtf(ss * (1.f / D_MODEL) + EPS);
    float s2 = 0.f;
#pragma unroll
    for (int j = 0; j < 8; ++j) {
        const float4 gp = *(const float4*)(g_post + (lane + 64 * j) * 4); const float4 xv = xr[lane + 64 * j];
        v[j].x = xv.x + v[j].x * r * gp.x; v[j].y = xv.y + v[j].y * r * gp.y; v[j].z = xv.z + v[j].z * r * gp.z; v[j].w = xv.w + v[j].w * r * gp.w;
        s2 += v[j].x * v[j].x + v[j].y * v[j].y + v[j].z * v[j].z + v[j].w * v[j].w;
        ((float4*)(X1 + (size_t)row * D_MODEL))[lane + 64 * j] = v[j];
    }
    s2 = wave_sum(s2);
    const float r2 = 1.f / sqrtf(s2 * (1.f / D_MODEL) + EPS);
#pragma unroll
    for (int j = 0; j < 8; ++j) {
        const float4 g2 = *(const float4*)(g_pre2 + (lane + 64 * j) * 4);
        ushort4 o; o.x = f2bf(v[j].x * r2 * g2.x); o.y = f2bf(v[j].y * r2 * g2.y); o.z = f2bf(v[j].z * r2 * g2.z); o.w = f2bf(v[j].w * r2 * g2.w);
        *(ushort4*)(H2 + (size_t)row * D_MODEL + (lane + 64 * j) * 4) = o;
    }
}
__global__ void k_stageH(const bf16_t* __restrict__ GRAW, bf16_t* UPACT, const float* __restrict__ cw, const float* __restrict__ cb) {
    const size_t i = (size_t)blockIdx.x * 256 + threadIdx.x;
    const int c = (int)(i % D_FF); const int row = (int)(i / D_FF); const int t = row % SEQ;
    float a = cb[c];
#pragma unroll
    for (int j = 0; j < 3; ++j) { const int tt = t - 2 + j; if (tt >= 0) a += cw[j * D_FF + c] * bf2f(GRAW[(size_t)(row - 2 + j) * D_FF + c]); }
    UPACT[i] = f2bf(gelu_tanh_f(a) * bf2f(UPACT[i]));
}
__global__ __launch_bounds__(256) void k_stageJ(const float* __restrict__ FFN, const float* __restrict__ g_post, float* OUT) {
    const int wave = threadIdx.x >> 6, lane = threadIdx.x & 63, row = blockIdx.x * 4 + wave;
    const float4* fr = (const float4*)(FFN + (size_t)row * D_MODEL); float4* orow = (float4*)(OUT + (size_t)row * D_MODEL);
    float4 v[8]; float ss = 0.f;
#pragma unroll
    for (int j = 0; j < 8; ++j) { v[j] = fr[lane + 64 * j]; ss += v[j].x * v[j].x + v[j].y * v[j].y + v[j].z * v[j].z + v[j].w * v[j].w; }
    ss = wave_sum(ss);
    const float r = 1.f / sqrtf(ss * (1.f / D_MODEL) + EPS);
#pragma unroll
    for (int j = 0; j < 8; ++j) {
        const float4 gp = *(const float4*)(g_post + (lane + 64 * j) * 4); float4 xv = orow[lane + 64 * j];
        xv.x += v[j].x * r * gp.x; xv.y += v[j].y * r * gp.y; xv.z += v[j].z * r * gp.z; xv.w += v[j].w * r * gp.w;
        orow[lane + 64 * j] = xv;
    }
}
}
namespace pg8 {
#define PG8_LAS __attribute__((address_space(3)))
typedef short bf16x8 __attribute__((ext_vector_type(8)));
typedef float f32x4 __attribute__((ext_vector_type(4)));
typedef float f32x2 __attribute__((ext_vector_type(2)));
typedef unsigned u32x4 __attribute__((ext_vector_type(4)));
typedef unsigned u32x2 __attribute__((ext_vector_type(2)));
constexpr int BM = 256, BK = 64, HALF = 128, HTB = HALF * BK * 2  , STAGE_BYTES = 8 * HTB, NXCD = 8, WGM = 8;

__host__ __device__ __forceinline__ int lds_byte(int r, int c) { const int st = (r >> 4) * 2 + (c >> 5), rr = r & 15, cc = c & 31, ob = rr * 64 + cc * 2; return st * 1024 + (ob ^ (((ob >> 9) & 1) << 5)); }
__host__ __device__ __forceinline__ void stage_rc(int b, int& R, int& C) { const int st = b / 1024, sb = b % 1024, swz = sb ^ (((sb >> 9) & 1) << 5); R = (st >> 1) * 16 + swz / 64; C = (st & 1) * 32 + (swz % 64) / 2; }
__host__ __device__ __forceinline__ int perm32(int rho) { const int n = rho >> 4, i = rho & 15; return 8 * (i >> 2) + 4 * n + (i & 3); }

struct Unit { int pm, pn, sel; };
struct Gemm { const bf16_t* A0; const bf16_t* A1; const bf16_t* B0; const bf16_t* B1; int K; };

struct StaticOrder {
    int nM, nN, nwg, G, c, nsel;
    __host__ __device__ void init(int M, int N, int G_, int c_, int nsel_ = 1) { nM = M / BM; nN = N / BM; nwg = nM * nN; G = G_; c = c_; nsel = nsel_; }
    __host__ __device__ bool next(int i, Unit& u) const {
        const int ti = (nsel == 2) ? (i >> 1) : i;
        const long L = (long)ti * G + c; if (L >= nwg) return false;
        int wgid = (int)L; { const int q = nwg / NXCD, r = nwg % NXCD, xcd = wgid % NXCD, off = wgid / NXCD; wgid = (xcd < r ? xcd * (q + 1) : r * (q + 1) + (xcd - r) * q) + off; }
        const int nig = WGM * nN, gid = wgid / nig, fm = gid * WGM, gsz = (nM - fm) < WGM ? (nM - fm) : WGM;
        u.pm = fm + ((wgid % nig) % gsz); u.pn = (wgid % nig) / gsz; u.sel = (nsel == 2) ? (i & 1) : 0; return true;
    }
};

__device__ __forceinline__ unsigned cvt_pk_bf16(float lo, float hi) { unsigned r; asm volatile("v_cvt_pk_bf16_f32 %0, %1, %2" : "=v"(r) : "v"(lo), "v"(hi)); return r; }
__device__ __forceinline__ float fast_sigmoid(float x) { return __builtin_amdgcn_rcpf(1.f + __builtin_amdgcn_exp2f(-1.4426950408889634f * x)); }
__device__ __forceinline__ float fast_silu(float x) { return x * fast_sigmoid(x); }
__device__ __forceinline__ u32x4 pack8(const f32x4 a, const f32x4 b) { u32x4 w; w.x = cvt_pk_bf16(a[0], a[1]); w.y = cvt_pk_bf16(a[2], a[3]); w.z = cvt_pk_bf16(b[0], b[1]); w.w = cvt_pk_bf16(b[2], b[3]); return w; }
__device__ __forceinline__ void unpack8(const u32x4 w, f32x4& a, f32x4& b) {
    a[0] = __uint_as_float(w.x << 16); a[1] = __uint_as_float(w.x & 0xffff0000u); a[2] = __uint_as_float(w.y << 16); a[3] = __uint_as_float(w.y & 0xffff0000u);
    b[0] = __uint_as_float(w.z << 16); b[1] = __uint_as_float(w.z & 0xffff0000u); b[2] = __uint_as_float(w.w << 16); b[3] = __uint_as_float(w.w & 0xffff0000u);
}

struct EpiF32 {
    static constexpr bool PERM = false, CHAIN = false;
    float* C; int ldc;
    __device__ __forceinline__ bool operator()(f32x4 (&acc)[2][2][4][2], const Unit& u, int wr, int wc, int fr, int fq) const {
        const int row0 = u.pm * BM + wr * 64 + fr, col0 = u.pn * BM + wc * 32 + 4 * fq;
#pragma unroll
        for (int ai = 0; ai < 2; ++ai)
#pragma unroll
            for (int m = 0; m < 4; ++m) { float* rowp = C + (size_t)(row0 + ai * HALF + m * 16) * ldc + col0;
#pragma unroll
                for (int bj = 0; bj < 2; ++bj)
#pragma unroll
                    for (int n = 0; n < 2; ++n) *(f32x4*)(rowp + bj * HALF + n * 16) = acc[ai][bj][m][n]; }
        return false;
    }
};
struct EpiSplitBf16 {
    static constexpr bool PERM = true, CHAIN = false;
    bf16_t* O0; bf16_t* O1; int ntile0; int ldc;
    __device__ __forceinline__ bool operator()(f32x4 (&acc)[2][2][4][2], const Unit& u, int wr, int wc, int fr, int fq) const {
        const int row0 = u.pm * BM + wr * 64 + fr; const bool second = u.pn >= ntile0; bf16_t* base = second ? O1 : O0;
        const int col0 = (second ? u.pn - ntile0 : u.pn) * BM + wc * 32 + 8 * fq;
#pragma unroll
        for (int ai = 0; ai < 2; ++ai)
#pragma unroll
            for (int m = 0; m < 4; ++m) { bf16_t* rowp = base + (size_t)(row0 + ai * HALF + m * 16) * ldc + col0;
#pragma unroll
                for (int bj = 0; bj < 2; ++bj) *(u32x4*)(rowp + bj * HALF) = pack8(acc[ai][bj][m][0], acc[ai][bj][m][1]); }
        return false;
    }
};
struct EpiInProj {
    static constexpr bool PERM = true, CHAIN = false;
    unsigned char* ws; const float* b_in;
    __device__ __forceinline__ bool operator()(f32x4 (&acc)[2][2][4][2], const Unit& u, int wr, int wc, int fr, int fq) const {
        float* LOGF = (float*)(ws + WS_LOGF); const float* LB = (const float*)(ws + WS_LB);
        const int pn = u.pn; const int seg = pn < 28 ? (pn >> 2) : (pn < 36 ? 7 : 8);
        const int ctile = pn < 28 ? (pn & 3) : (pn < 36 ? pn - 28 : pn - 36);
        const int ld = seg < 7 ? 1024 : 2048;
        const int cseg0 = ctile * BM + wc * 32 + 8 * fq;
        const int borig0 = pn * BM + wc * 32 + 8 * fq + (pn >= 28 ? 8 : 0);
        const int row0 = u.pm * BM + wr * 64 + fr;
        const size_t oboff = seg == 0 ? WS_QH : seg == 2 ? WS_VH : seg == 3 ? WS_GH : seg == 4 ? WS_MQK : seg == 5 ? WS_MV : seg == 6 ? WS_MO : seg == 7 ? WS_GA : WS_GB;
        bf16_t* ob = (bf16_t*)(ws + oboff);
#pragma unroll
        for (int bj = 0; bj < 2; ++bj) {
            const f32x4 b0 = *(const f32x4*)(b_in + borig0 + bj * HALF), b1 = *(const f32x4*)(b_in + borig0 + bj * HALF + 4);
            f32x4 l0 = (f32x4){0.f, 0.f, 0.f, 0.f}, l1 = l0;
            if (seg == 1) { l0 = *(const f32x4*)(LB + cseg0 + bj * HALF); l1 = *(const f32x4*)(LB + cseg0 + bj * HALF + 4); }
#pragma unroll
            for (int ai = 0; ai < 2; ++ai)
#pragma unroll
                for (int m = 0; m < 4; ++m) {
                    f32x4 v0 = acc[ai][bj][m][0] + b0, v1 = acc[ai][bj][m][1] + b1;
                    const size_t off = (size_t)(row0 + ai * HALF + m * 16) * ld + cseg0 + bj * HALF;
                    if (seg == 1) {
#pragma unroll
                        for (int j = 0; j < 4; ++j) { v0[j] = __logf(l0[j] + (1.f - l0[j]) * fast_sigmoid(v0[j])); v1[j] = __logf(l1[j] + (1.f - l1[j]) * fast_sigmoid(v1[j])); }
                        *(f32x4*)(LOGF + off) = v0; *(f32x4*)(LOGF + off + 4) = v1;
                    } else {
                        if (seg == 0) {
#pragma unroll
                            for (int j = 0; j < 4; ++j) { v0[j] = fast_silu(v0[j]) * 0.08838834764831845f; v1[j] = fast_silu(v1[j]) * 0.08838834764831845f; }
                        } else if (seg == 3) {
#pragma unroll
                            for (int j = 0; j < 4; ++j) { v0[j] = fast_silu(v0[j]); v1[j] = fast_silu(v1[j]); }
                        } else if (seg >= 6) {
#pragma unroll
                            for (int j = 0; j < 4; ++j) { v0[j] = fast_sigmoid(v0[j]); v1[j] = fast_sigmoid(v1[j]); }
                        }
                        *(u32x4*)(ob + off) = pack8(v0, v1);
                    }
                }
        }
        return false;
    }
};
struct EpiMerge {
    static constexpr bool PERM = true, CHAIN = true;
    const bf16_t* GA; const bf16_t* GB; bf16_t* OUT;
    __device__ __forceinline__ bool operator()(f32x4 (&acc)[2][2][4][2], const Unit& u, int wr, int wc, int fr, int fq) const {
        const int row0 = u.pm * BM + wr * 64 + fr, col0 = u.pn * BM + wc * 32 + 8 * fq;
#pragma unroll
        for (int ai = 0; ai < 2; ++ai)
#pragma unroll
            for (int m = 0; m < 4; ++m)
#pragma unroll
                for (int bj = 0; bj < 2; ++bj) {
                    const size_t off = (size_t)(row0 + ai * HALF + m * 16) * 2048 + col0 + bj * HALF;
                    f32x4 gb0, gb1; unpack8(*(const u32x4*)(GB + off), gb0, gb1);
                    if (u.sel == 0) {
                        f32x4 ga0, ga1; unpack8(*(const u32x4*)(GA + off), ga0, ga1);
#pragma unroll
                        for (int j = 0; j < 4; ++j) { acc[ai][bj][m][0][j] *= ga0[j] * __builtin_amdgcn_rcpf(fmaxf(gb0[j], 1e-30f)); acc[ai][bj][m][1][j] *= ga1[j] * __builtin_amdgcn_rcpf(fmaxf(gb1[j], 1e-30f)); }
                    } else {
                        *(u32x4*)(OUT + off) = pack8(acc[ai][bj][m][0] * gb0, acc[ai][bj][m][1] * gb1);
                    }
                }
        return u.sel == 0;
    }
};

template <class Epi, class Sched, bool ALIGN_EPI = false, bool SP2 = false>
__device__ __forceinline__ void gemm_phase(PG8_LAS unsigned char* lds, const Gemm g, const Sched& S, const Epi& E) {
    int tid_ = threadIdx.x; asm volatile("" : "+v"(tid_));
    const int tid = tid_, wid = __builtin_amdgcn_readfirstlane(tid >> 6), lane = tid & 63, wr = wid >> 2, wc = wid & 3, fr = lane & 15, fq = lane >> 4;
    const int K = g.K, nt = K / BK;
    unsigned voffA[2], voffB[2];
#pragma unroll
    for (int i = 0; i < 2; ++i) { int R, C; stage_rc(tid * 16 + i * 8192, R, C); const int Rb = Epi::PERM ? ((R & ~31) + perm32(R & 31)) : R;
        voffA[i] = (unsigned)(R * K + C) * 2u; voffB[i] = (unsigned)(Rb * K + C) * 2u; }
    const size_t kstep = (size_t)(BK * 2);
    const size_t hstep = (size_t)HALF * K * 2;
    const size_t tstep = 2 * hstep;
    const unsigned ldsw = (unsigned)wid * 1024u;
    const int aoff = lds_byte(wr * 64 + fr, fq * 8), boff = lds_byte(wc * 32 + fr, fq * 8);
#define PG8_SA(b, h) (((b) * 2 + (h)) * HTB)
#define PG8_SB(b, h) ((4 + (b) * 2 + (h)) * HTB)
#define PG8_STAGE(bufoff, gbase, voff) do { _Pragma("unroll") for (int _i = 0; _i < 2; ++_i) \
        __builtin_amdgcn_global_load_lds((const unsigned*)((const char*)(gbase) + (voff)[_i]), (PG8_LAS unsigned*)(lds + (bufoff) + ldsw + _i * 8192), 16, 0, 0); } while (0)
#define PG8_LDA(dst, b, h) do { _Pragma("unroll") for (int m = 0; m < 4; ++m) _Pragma("unroll") for (int k = 0; k < 2; ++k) dst[m][k] = *(const PG8_LAS bf16x8*)(lds + PG8_SA(b, h) + aoff + m * 2048 + k * 1024); } while (0)
#define PG8_LDB(dst, b, h) do { _Pragma("unroll") for (int n = 0; n < 2; ++n) _Pragma("unroll") for (int k = 0; k < 2; ++k) dst[n][k] = *(const PG8_LAS bf16x8*)(lds + PG8_SB(b, h) + boff + n * 2048 + k * 1024); } while (0)
#define PG8_MMA(ai, bj, At, Bt) do { __builtin_amdgcn_s_setprio(1); _Pragma("unroll") for (int m = 0; m < 4; ++m) _Pragma("unroll") for (int n = 0; n < 2; ++n) _Pragma("unroll") for (int k = 0; k < 2; ++k) \
        acc[ai][bj][m][n] = __builtin_amdgcn_mfma_f32_16x16x32_bf16(Bt[n][k], At[m][k], acc[ai][bj][m][n], 0, 0, 0); __builtin_amdgcn_s_setprio(0); } while (0)
#define PG8_WAIT_V(n) asm volatile("s_waitcnt vmcnt(" #n ")" ::: "memory")
#define PG8_WAIT_L(n) asm volatile("s_waitcnt lgkmcnt(" #n ")" ::: "memory")
#define PG8_BAR __builtin_amdgcn_s_barrier()
#define PG8_SCHED __builtin_amdgcn_sched_barrier(0)
    Unit cur, nxt; int ui = 0;
    if (!S.next(0, cur)) return;
    f32x4 acc[2][2][4][2];
#pragma unroll
    for (int a = 0; a < 2; ++a)
#pragma unroll
        for (int b = 0; b < 2; ++b)
#pragma unroll
            for (int m = 0; m < 4; ++m)
#pragma unroll
                for (int n = 0; n < 2; ++n) acc[a][b][m][n] = (f32x4){0.f, 0.f, 0.f, 0.f};
    bf16x8 At[4][2], B0[2][2], B1[2][2];
    const char* cA = (const char*)(cur.sel ? g.A1 : g.A0) + (size_t)cur.pm * tstep; const char* cB = (const char*)(cur.sel ? g.B1 : g.B0) + (size_t)cur.pn * tstep;
    if constexpr (SP2) {
        PG8_STAGE(PG8_SB(0, 0), cB, voffB); PG8_STAGE(PG8_SB(0, 1), cB + hstep, voffB); PG8_STAGE(PG8_SA(0, 0), cA, voffA); PG8_STAGE(PG8_SA(0, 1), cA + hstep, voffA);
        if (wr == 1) PG8_BAR;
        PG8_WAIT_V(2); PG8_BAR;
        PG8_STAGE(PG8_SB(1, 0), cB + kstep, voffB); PG8_STAGE(PG8_SA(1, 0), cA + kstep, voffA); PG8_STAGE(PG8_SB(1, 1), cB + hstep + kstep, voffB);
        PG8_WAIT_V(6); PG8_BAR;
    } else {
        PG8_STAGE(PG8_SB(0, 0), cB, voffB); PG8_STAGE(PG8_SA(0, 0), cA, voffA); PG8_STAGE(PG8_SB(0, 1), cB + hstep, voffB); PG8_STAGE(PG8_SA(0, 1), cA + hstep, voffA);
        if (wr == 1) PG8_BAR;
        PG8_WAIT_V(4); PG8_BAR;
        PG8_STAGE(PG8_SB(1, 0), cB + kstep, voffB); PG8_STAGE(PG8_SA(1, 0), cA + kstep, voffA); PG8_STAGE(PG8_SB(1, 1), cB + hstep + kstep, voffB);
        PG8_WAIT_V(6); PG8_BAR;
    }
    for (;;) {
        const bool has_next = S.next(ui + 1, nxt);
        const char* nA = has_next ? (const char*)(nxt.sel ? g.A1 : g.A0) + (size_t)nxt.pm * tstep : cA; const char* nB = has_next ? (const char*)(nxt.sel ? g.B1 : g.B0) + (size_t)nxt.pn * tstep : cB;
        for (int t = 0; t < nt; t += 2) {
            const bool last = (t == nt - 2);
            const char* a1 = cA + (size_t)(t + 1) * kstep;
            const char* a2 = last ? nA : cA + (size_t)(t + 2) * kstep; const char* b2 = last ? nB : cB + (size_t)(t + 2) * kstep;
            const char* a3 = a2 + kstep; const char* b3 = b2 + kstep;
            if constexpr (SP2) {
            PG8_LDB(B0, 0, 0); PG8_LDB(B1, 0, 1); PG8_SCHED; PG8_LDA(At, 0, 0); PG8_STAGE(PG8_SA(1, 1), a1 + hstep, voffA);
            PG8_WAIT_V(8); PG8_WAIT_L(0); PG8_BAR; PG8_MMA(0, 0, At, B0); PG8_MMA(0, 1, At, B1); PG8_BAR; PG8_SCHED;
            PG8_LDA(At, 0, 1); PG8_STAGE(PG8_SB(0, 0), b2, voffB); PG8_STAGE(PG8_SB(0, 1), b2 + hstep, voffB); PG8_STAGE(PG8_SA(0, 0), a2, voffA);
            PG8_WAIT_V(8); PG8_WAIT_L(0); PG8_BAR; PG8_MMA(1, 0, At, B0); PG8_MMA(1, 1, At, B1); PG8_BAR; PG8_SCHED;
            PG8_LDB(B0, 1, 0); PG8_LDB(B1, 1, 1); PG8_SCHED; PG8_LDA(At, 1, 0); PG8_STAGE(PG8_SA(0, 1), a2 + hstep, voffA);
            PG8_WAIT_V(8); PG8_WAIT_L(0); PG8_BAR; PG8_MMA(0, 0, At, B0); PG8_MMA(0, 1, At, B1); PG8_BAR; PG8_SCHED;
            PG8_LDA(At, 1, 1); PG8_STAGE(PG8_SB(1, 0), b3, voffB); PG8_STAGE(PG8_SB(1, 1), b3 + hstep, voffB); PG8_STAGE(PG8_SA(1, 0), a3, voffA);
            PG8_WAIT_V(8); PG8_WAIT_L(0); PG8_BAR; PG8_MMA(1, 0, At, B0); PG8_MMA(1, 1, At, B1); PG8_BAR; PG8_SCHED;
            } else {
            PG8_LDB(B0, 0, 0); PG8_SCHED; PG8_LDA(At, 0, 0); PG8_STAGE(PG8_SA(1, 1), a1 + hstep, voffA);
            PG8_WAIT_L(8); PG8_BAR; PG8_WAIT_L(0); PG8_MMA(0, 0, At, B0); PG8_BAR; PG8_SCHED;
            PG8_LDB(B1, 0, 1); PG8_STAGE(PG8_SB(0, 0), b2, voffB);
            PG8_BAR; PG8_WAIT_L(0); PG8_MMA(0, 1, At, B1); PG8_BAR;
            PG8_LDA(At, 0, 1); PG8_STAGE(PG8_SA(0, 0), a2, voffA);
            PG8_BAR; PG8_WAIT_L(0); PG8_MMA(1, 0, At, B0); PG8_BAR; PG8_SCHED;
            PG8_STAGE(PG8_SB(0, 1), b2 + hstep, voffB);
            PG8_WAIT_V(6); PG8_BAR; PG8_MMA(1, 1, At, B1); PG8_BAR;
            PG8_LDB(B0, 1, 0); PG8_SCHED; PG8_LDA(At, 1, 0); PG8_STAGE(PG8_SA(0, 1), a2 + hstep, voffA);
            PG8_WAIT_L(8); PG8_BAR; PG8_WAIT_L(0); PG8_MMA(0, 0, At, B0); PG8_BAR; PG8_SCHED;
            PG8_LDB(B1, 1, 1); PG8_STAGE(PG8_SB(1, 0), b3, voffB);
            PG8_BAR; PG8_WAIT_L(0); PG8_MMA(0, 1, At, B1); PG8_BAR;
            PG8_LDA(At, 1, 1); PG8_STAGE(PG8_SA(1, 0), a3, voffA);
            PG8_BAR; PG8_WAIT_L(0); PG8_MMA(1, 0, At, B0); PG8_BAR; PG8_SCHED;
            PG8_STAGE(PG8_SB(1, 1), b3 + hstep, voffB);
            PG8_WAIT_V(6); PG8_BAR; PG8_MMA(1, 1, At, B1); PG8_BAR;
            }
        }
        if constexpr (ALIGN_EPI) { if (wr == 0) PG8_BAR; }
        const bool keep = E(acc, cur, wr, wc, fr, fq);
        if (!has_next) break;
        if (!(Epi::CHAIN && keep)) {
#pragma unroll
            for (int a = 0; a < 2; ++a)
#pragma unroll
                for (int b = 0; b < 2; ++b)
#pragma unroll
                    for (int m = 0; m < 4; ++m)
#pragma unroll
                        for (int n = 0; n < 2; ++n) acc[a][b][m][n] = (f32x4){0.f, 0.f, 0.f, 0.f};
        }
        cur = nxt; cA = nA; cB = nB; ++ui;
        if constexpr (ALIGN_EPI) { if (wr == 1) PG8_BAR; }
    }
    PG8_WAIT_V(0);
    if constexpr (!ALIGN_EPI) { if (wr == 0) PG8_BAR; }
    PG8_BAR;
#undef PG8_SA
#undef PG8_SB
#undef PG8_STAGE
#undef PG8_LDA
#undef PG8_LDB
#undef PG8_MMA
#undef PG8_WAIT_V
#undef PG8_WAIT_L
#undef PG8_BAR
#undef PG8_SCHED
}
}
constexpr int NWAVES = 8;
constexpr int RING_OFF = 0, RING_BYTES = 131072;
constexpr int LDSCTL_OFF = RING_BYTES, MISC_OFF = LDSCTL_OFF + 320;
constexpr int LDS_BYTES = 147456;
constexpr int CW_TMO = 0, CW_CODE = 1;
constexpr int CW_BAR = 4096;
#define GAS __attribute__((address_space(1)))
#define LAS __attribute__((address_space(3)))
typedef unsigned v4u __attribute__((ext_vector_type(4)));
typedef float f32x4 __attribute__((ext_vector_type(4)));
typedef GAS unsigned gu32;
#define RLX_AGENT __ATOMIC_RELAXED, __HIP_MEMORY_SCOPE_AGENT
#define LDS_WAIT() asm volatile("s_waitcnt lgkmcnt(0)" ::: "memory")
#define VM_WAIT() asm volatile("s_waitcnt vmcnt(0)" ::: "memory")
__device__ __forceinline__ unsigned pk2(float lo, float hi) { return (unsigned)f2bf(lo) | ((unsigned)f2bf(hi) << 16); }

#define XB_TMO      128
#define XB_XCNT(j)  (256  + 64 * (j))
#define XB_XSUB(j)  (1280 + 64 * (j))
#define XB_XGEN(j)  (2304 + 64 * (j))
#define XB_TOP      3328
#define XB_TOPGEN   3392
#define XCD_BAR_WORDS 3456
#define XB_SPIN_CAP (1u << 18)
__device__ __forceinline__ unsigned xb_ld(unsigned* p)              { return __hip_atomic_load(p, __ATOMIC_RELAXED, __HIP_MEMORY_SCOPE_AGENT); }
__device__ __forceinline__ unsigned xb_add(unsigned* p, unsigned v) { return __hip_atomic_fetch_add(p, v, __ATOMIC_RELAXED, __HIP_MEMORY_SCOPE_AGENT); }
__device__ __forceinline__ unsigned xb_xcc_id() { return (unsigned)__builtin_amdgcn_s_getreg((3 << 11) | 20) & 0xFu; }
#define XB_SPIN(cond, bar) do { unsigned _sp = 0; while (cond) { __builtin_amdgcn_s_sleep(1); \
    if ((++_sp & 255u) == 0u) { if (xb_ld(&(bar)[XB_TMO])) break; if (_sp > XB_SPIN_CAP) { atomicAdd(&(bar)[XB_TMO], 1u); break; } } } } while (0)
struct XcdBarrier { unsigned* bar; unsigned x; volatile LAS unsigned* st; };
__device__ __forceinline__ XcdBarrier xcd_barrier_post(unsigned* bar, volatile LAS unsigned* st) {
    XcdBarrier b; b.bar = bar; b.x = xb_xcc_id(); b.st = st;
    if (threadIdx.x == 0) (void)xb_add(&bar[XB_XCNT(b.x)], 1u);
    return b;
}
__device__ __forceinline__ void xcd_barrier_complete(unsigned* bar, unsigned x, unsigned& nloc, unsigned& nx) {
    const unsigned G = gridDim.x * gridDim.y * gridDim.z;
    unsigned sum, cnt, mine, sp = 0u;
    for (;;) {
        sum = 0u; cnt = 0u; mine = 0u;
#pragma unroll
        for (unsigned j = 0; j < 16; ++j) { const unsigned c = xb_ld(&bar[XB_XCNT(j)]); sum += c; cnt += (c > 0u) ? 1u : 0u; mine = (j == x) ? c : mine; }
        if (sum == G) break;
        __builtin_amdgcn_s_sleep(1);
        if ((++sp & 255u) == 0u) { if (xb_ld(&bar[XB_TMO])) break; if (sp > XB_SPIN_CAP) { atomicAdd(&bar[XB_TMO], 1u); break; } }
    }
    nloc = mine > 0u ? mine : 1u; nx = cnt > 0u ? cnt : 1u;
}
__device__ __forceinline__ void xcd_barrier(const XcdBarrier& b) {
    asm volatile("s_waitcnt vmcnt(0)" ::: "memory");
    __syncthreads();
    if (threadIdx.x == 0) {
        unsigned* bar = b.bar;
        __builtin_amdgcn_s_waitcnt(0);
        unsigned nloc = b.st[0], nx = b.st[1];
        if (nloc == 0u) { xcd_barrier_complete(bar, b.x, nloc, nx); b.st[0] = nloc; b.st[1] = nx; }
        const unsigned old = xb_add(&bar[XB_XSUB(b.x)], 1u);
        const unsigned gen = old / nloc;
        if (old + 1u == (gen + 1u) * nloc) {
            __builtin_amdgcn_fence(__ATOMIC_RELEASE, "agent");
            asm volatile("s_waitcnt vmcnt(0)" ::: "memory");
            const unsigned og = xb_add(&bar[XB_TOP], 1u);
            const unsigned tg = og / nx;
            if (og + 1u == (tg + 1u) * nx) xb_add(&bar[XB_TOPGEN], 1u);
            else XB_SPIN(xb_ld(&bar[XB_TOPGEN]) == tg, bar);
            __builtin_amdgcn_fence(__ATOMIC_ACQUIRE, "agent");
            xb_add(&bar[XB_XGEN(b.x)], 1u);
            asm volatile("s_waitcnt vmcnt(0)" ::: "memory");
        } else {
            XB_SPIN(xb_ld(&bar[XB_XGEN(b.x)]) == gen, bar);
            __builtin_amdgcn_fence(__ATOMIC_ACQUIRE, "agent");
            asm volatile("s_waitcnt vmcnt(0)" ::: "memory");
        }
    }
    __syncthreads();
}

struct Args {
    const float *x, *g_mix_pre, *g_mix_post, *g_ffn_pre, *g_ffn_post, *w_in, *b_in, *lb_logits, *hg_norm, *ml_conv_w, *ml_conv_b, *ml_norm, *w_up_a, *w_up_b, *w_out, *ffn_w_gate, *ffn_w_up,
        *ffn_conv_w, *ffn_conv_b, *ffn_w_down;
    float* out; unsigned char* ws;
    int ph_lo, ph_hi, li, pad;
};
struct Frame { LAS unsigned char* lds; int tid, lane, wave, vcu, G; };

__device__ __forceinline__ void transpose_item(const float* W, int K, int ldw, int nblk, int gap_at, bf16_t* WT, LAS float* scr, int item, int lane) {
    const int kb = item / nblk, nb = item % nblk, k0 = 64 * kb, n0 = 32 * nb, ns = n0 + (n0 >= gap_at ? 8 : 0);
#pragma unroll 8
    for (int i = 0; i < 32; ++i) { const int kk = 2 * i + (lane >> 5); scr[kk * 33 + (lane & 31)] = W[(size_t)(k0 + kk) * ldw + ns + (lane & 31)]; }
    LDS_WAIT(); asm volatile("" ::: "memory");
    const int c = lane & 7;
#pragma unroll
    for (int j = 0; j < 4; ++j) { const int n = (lane >> 3) + 8 * j; const LAS float* s = scr + (8 * c) * 33 + n;
        v4u o; o.x = pk2(s[0 * 33], s[1 * 33]); o.y = pk2(s[2 * 33], s[3 * 33]); o.z = pk2(s[4 * 33], s[5 * 33]); o.w = pk2(s[6 * 33], s[7 * 33]);
        *(GAS v4u*)(WT + (size_t)(n0 + n) * K + k0 + 8 * c) = o; }
    LDS_WAIT(); asm volatile("" ::: "memory");
}
__device__ __forceinline__ void prep_row(const Args& a, const LAS float* w8t, int row, int lane) {
    asm volatile("" ::: "memory");
    const float4* xr = (const float4*)(a.x + (size_t)row * D_MODEL);
    bf16_t* HB = (bf16_t*)(a.ws + WS_HB); float* GATES = (float*)(a.ws + WS_GATES);
    float4 v[8]; float ss = 0.f;
#pragma unroll
    for (int j = 0; j < 8; ++j) { v[j] = xr[lane + 64 * j]; ss += v[j].x * v[j].x + v[j].y * v[j].y + v[j].z * v[j].z + v[j].w * v[j].w; }
    ss = wave_sum(ss);
    const float r = 1.f / sqrtf(ss * (1.f / D_MODEL) + EPS);
    float g[8];
#pragma unroll
    for (int q = 0; q < 8; ++q) g[q] = 0.f;
#pragma unroll
    for (int j = 0; j < 8; ++j) {
        const int d0 = (lane + 64 * j) * 4;
        const float4 gn = *(const float4*)(a.g_mix_pre + d0);
        const float h0 = v[j].x * r * gn.x, h1 = v[j].y * r * gn.y, h2 = v[j].z * r * gn.z, h3 = v[j].w * r * gn.w;
        uint2 o; o.x = pk2(h0, h1); o.y = pk2(h2, h3);
        *(uint2*)(HB + (size_t)row * D_MODEL + d0) = o;
#pragma unroll
        for (int q = 0; q < 8; ++q) { const f32x4 w = *(const LAS f32x4*)(w8t + q * 2048 + d0); g[q] += (h0 * w[0] + h1 * w[1]) + (h2 * w[2] + h3 * w[3]); }
        asm volatile("" ::: "memory");
    }
#pragma unroll
    for (int q = 0; q < 8; ++q) g[q] = wave_sum(g[q]);
    if (lane == 0) {
#pragma unroll
        for (int q = 0; q < 8; ++q) GATES[(size_t)row * 8 + q] = g[q] + a.b_in[C_IG + q];
    }
}
__device__ __forceinline__ void phase_prep(const Args& a, const Frame& F) {
    LAS float* scr = (LAS float*)(F.lds + RING_OFF + F.wave * 16384);
    const int gw = F.vcu * NWAVES + F.wave, NGW = F.G * NWAVES;
    constexpr int I_IN = (2048 / 64) * (11264 / 32), I_A = (1024 / 64) * (2048 / 32), I_O = (2048 / 64) * (2048 / 32);
    constexpr int NITEMS = I_IN + 2 * I_A + I_O;
    for (int it = gw; it < NITEMS; it += NGW) {
        int r = it;
        if (r < I_IN) { transpose_item(a.w_in, 2048, IN_W, 11264 / 32, 7168, (bf16_t*)(a.ws + WS_WINT), scr, r, F.lane); continue; } r -= I_IN;
        if (r < I_A) { transpose_item(a.w_up_a, 1024, 2048, 2048 / 32, 1 << 30, (bf16_t*)(a.ws + WS_WA), scr, r, F.lane); continue; } r -= I_A;
        if (r < I_A) { transpose_item(a.w_up_b, 1024, 2048, 2048 / 32, 1 << 30, (bf16_t*)(a.ws + WS_WB), scr, r, F.lane); continue; } r -= I_A;
        transpose_item(a.w_out, 2048, 2048, 2048 / 32, 1 << 30, (bf16_t*)(a.ws + WS_WOUT), scr, r, F.lane);
    }
    __syncthreads();
    LAS float* w8t = (LAS float*)(F.lds + RING_OFF);
    for (int d = F.tid; d < D_MODEL; d += NWAVES * 64) { const float4* wr = (const float4*)(a.w_in + (size_t)d * IN_W + C_IG); const float4 w0 = wr[0], w1 = wr[1];
        w8t[0 * 2048 + d] = w0.x; w8t[1 * 2048 + d] = w0.y; w8t[2 * 2048 + d] = w0.z; w8t[3 * 2048 + d] = w0.w; w8t[4 * 2048 + d] = w1.x; w8t[5 * 2048 + d] = w1.y; w8t[6 * 2048 + d] = w1.z; w8t[7 * 2048 + d] = w1.w; }
    __syncthreads();
    for (int m = gw; m < M_TOK; m += NGW) prep_row(a, w8t, m, F.lane);
    if (gw < 16) { const int c = gw * 64 + F.lane; const float l0 = a.lb_logits[c], l1 = a.lb_logits[HG_W + c], mx = fmaxf(l0, l1); const float e0 = expf(l0 - mx), e1 = expf(l1 - mx); ((float*)(a.ws + WS_LB))[c] = e0 / (e0 + e1); }
}
__device__ __forceinline__ void phase_ffn_weights(const Args& a, const Frame& F) {
    LAS float* scr = (LAS float*)(F.lds + RING_OFF + F.wave * 16384);
    const int gw = F.vcu * NWAVES + F.wave, NGW = F.G * NWAVES;
    constexpr int I_G = (2048 / 64) * (D_FF / 32), I_D = (D_FF / 64) * (2048 / 32);
    for (int it = gw; it < 2 * I_G + I_D; it += NGW) {
        int r = it;
        if (r < I_G) { transpose_item(a.ffn_w_gate, 2048, D_FF, D_FF / 32, 1 << 30, (bf16_t*)(a.ws + WS_WG), scr, r, F.lane); continue; } r -= I_G;
        if (r < I_G) { transpose_item(a.ffn_w_up, 2048, D_FF, D_FF / 32, 1 << 30, (bf16_t*)(a.ws + WS_WU), scr, r, F.lane); continue; } r -= I_G;
        transpose_item(a.ffn_w_down, D_FF, 2048, 2048 / 32, 1 << 30, (bf16_t*)(a.ws + WS_WD), scr, r, F.lane);
    }
}

__device__ __forceinline__ void stageF_row(const Args& a, int row, int lane) {
    const float4* mr = (const float4*)((const float*)(a.ws + WS_MIX) + (size_t)row * D_MODEL); const float4* xr = (const float4*)(a.x + (size_t)row * D_MODEL);
    bf16_t* H2 = (bf16_t*)(a.ws + WS_H2);
    float4 v[8]; float ss = 0.f;
#pragma unroll
    for (int j = 0; j < 8; ++j) { v[j] = mr[lane + 64 * j]; ss += v[j].x * v[j].x + v[j].y * v[j].y + v[j].z * v[j].z + v[j].w * v[j].w; }
    ss = wave_sum(ss);
    const float r = 1.f / sqrtf(ss * (1.f / D_MODEL) + EPS);
    float s2 = 0.f;
#pragma unroll
    for (int j = 0; j < 8; ++j) {
        const float4 gp = *(const float4*)(a.g_mix_post + (lane + 64 * j) * 4); const float4 xv = xr[lane + 64 * j];
        v[j].x = xv.x + v[j].x * r * gp.x; v[j].y = xv.y + v[j].y * r * gp.y; v[j].z = xv.z + v[j].z * r * gp.z; v[j].w = xv.w + v[j].w * r * gp.w;
        s2 += v[j].x * v[j].x + v[j].y * v[j].y + v[j].z * v[j].z + v[j].w * v[j].w;
        ((float4*)(a.out + (size_t)row * D_MODEL))[lane + 64 * j] = v[j];
    }
    s2 = wave_sum(s2);
    const float r2 = 1.f / sqrtf(s2 * (1.f / D_MODEL) + EPS);
#pragma unroll
    for (int j = 0; j < 8; ++j) {
        const float4 g2 = *(const float4*)(a.g_ffn_pre + (lane + 64 * j) * 4);
        uint2 o; o.x = pk2(v[j].x * r2 * g2.x, v[j].y * r2 * g2.y); o.y = pk2(v[j].z * r2 * g2.z, v[j].w * r2 * g2.w);
        *(uint2*)(H2 + (size_t)row * D_MODEL + (lane + 64 * j) * 4) = o;
    }
}
__device__ __forceinline__ void stageJ_row(const Args& a, int row, int lane) {
    const float4* fr = (const float4*)((const float*)(a.ws + WS_FFN) + (size_t)row * D_MODEL); float4* orow = (float4*)(a.out + (size_t)row * D_MODEL);
    float4 v[8]; float ss = 0.f;
#pragma unroll
    for (int j = 0; j < 8; ++j) { v[j] = fr[lane + 64 * j]; ss += v[j].x * v[j].x + v[j].y * v[j].y + v[j].z * v[j].z + v[j].w * v[j].w; }
    ss = wave_sum(ss);
    const float r = 1.f / sqrtf(ss * (1.f / D_MODEL) + EPS);
#pragma unroll
    for (int j = 0; j < 8; ++j) {
        const float4 gp = *(const float4*)(a.g_ffn_post + (lane + 64 * j) * 4); float4 xv = orow[lane + 64 * j];
        xv.x += v[j].x * r * gp.x; xv.y += v[j].y * r * gp.y; xv.z += v[j].z * r * gp.z; xv.w += v[j].w * r * gp.w;
        orow[lane + 64 * j] = xv;
    }
}
__device__ __forceinline__ float fast_gelu_tanh(float x) {
    const float u2 = 1.5957691216057308f * (x + 0.044715f * x * x * x);
    return x * __builtin_amdgcn_rcpf(1.f + __builtin_amdgcn_exp2f(-1.4426950408889634f * u2));
}
__device__ __forceinline__ void phase_H(const Args& a, const Frame& F) {
    const bf16_t* GRAW = (const bf16_t*)(a.ws + WS_GRAW); bf16_t* UP = (bf16_t*)(a.ws + WS_UP);
    constexpr int CG = D_FF / 8;
    const size_t total = (size_t)M_TOK * CG, stride = (size_t)F.G * 512;
    for (size_t i = (size_t)F.vcu * 512 + F.tid; i < total; i += stride) {
        const int row = (int)(i / CG), cg = (int)(i % CG), c0 = cg * 8, t = row % SEQ;
        float acc[8];
        { const float4 b0 = *(const float4*)(a.ffn_conv_b + c0), b1 = *(const float4*)(a.ffn_conv_b + c0 + 4); acc[0] = b0.x; acc[1] = b0.y; acc[2] = b0.z; acc[3] = b0.w; acc[4] = b1.x; acc[5] = b1.y; acc[6] = b1.z; acc[7] = b1.w; }
#pragma unroll
        for (int j = 0; j < 3; ++j) {
            const int tt = t - 2 + j;
            if (tt >= 0) {
                const v4u g = *(const v4u*)(GRAW + (size_t)(row - 2 + j) * D_FF + c0);
                const float4 w0 = *(const float4*)(a.ffn_conv_w + (size_t)j * D_FF + c0), w1 = *(const float4*)(a.ffn_conv_w + (size_t)j * D_FF + c0 + 4);
                acc[0] += w0.x * __uint_as_float(g.x << 16); acc[1] += w0.y * __uint_as_float(g.x & 0xffff0000u);
                acc[2] += w0.z * __uint_as_float(g.y << 16); acc[3] += w0.w * __uint_as_float(g.y & 0xffff0000u);
                acc[4] += w1.x * __uint_as_float(g.z << 16); acc[5] += w1.y * __uint_as_float(g.z & 0xffff0000u);
                acc[6] += w1.z * __uint_as_float(g.w << 16); acc[7] += w1.w * __uint_as_float(g.w & 0xffff0000u);
            }
        }
        v4u* up = (v4u*)(UP + (size_t)row * D_FF + c0); const v4u u = *up;
        const float uu[8] = {__uint_as_float(u.x << 16), __uint_as_float(u.x & 0xffff0000u), __uint_as_float(u.y << 16), __uint_as_float(u.y & 0xffff0000u),
                             __uint_as_float(u.z << 16), __uint_as_float(u.z & 0xffff0000u), __uint_as_float(u.w << 16), __uint_as_float(u.w & 0xffff0000u)};
        v4u o;
        o.x = pk2(fast_gelu_tanh(acc[0]) * uu[0], fast_gelu_tanh(acc[1]) * uu[1]); o.y = pk2(fast_gelu_tanh(acc[2]) * uu[2], fast_gelu_tanh(acc[3]) * uu[3]);
        o.z = pk2(fast_gelu_tanh(acc[4]) * uu[4], fast_gelu_tanh(acc[5]) * uu[5]); o.w = pk2(fast_gelu_tanh(acc[6]) * uu[6], fast_gelu_tanh(acc[7]) * uu[7]);
        *up = o;
    }
}
__device__ __forceinline__ void phase_mlconv(const Args& a, const Frame& F) {
    const bf16_t* MQK = (const bf16_t*)(a.ws + WS_MQK); float* MQA = (float*)(a.ws + WS_MQA);
    const size_t total = (size_t)M_TOK * 1024, stride = (size_t)F.G * 512;
    for (size_t i = (size_t)F.vcu * 512 + F.tid; i < total; i += stride) {
        const int c = (int)(i & 1023); const int row = (int)(i >> 10); const int t = row % SEQ;
        float s = a.ml_conv_b[c];
#pragma unroll
        for (int j = 0; j < 4; ++j) { const int tt = t - 3 + j; if (tt >= 0) s += a.ml_conv_w[j * 1024 + c] * bf2f(MQK[(size_t)(row - 3 + j) * 1024 + c]); }
        MQA[i] = silu_f(s);
    }
}
#define WAVE_SYNC() asm volatile("s_waitcnt lgkmcnt(0)" ::: "memory")
__device__ __forceinline__ void hgscan_item(const Args& a, LAS float* lds, int item, int lane) {
    const bf16_t* QH = (const bf16_t*)(a.ws + WS_QH); const float* LOGF = (const float*)(a.ws + WS_LOGF); const bf16_t* VH = (const bf16_t*)(a.ws + WS_VH); float* O = (float*)(a.ws + WS_OHG);
    LAS float* sq = lds; LAS float* sf = lds + 32 * 128; LAS float* sv = lds + 2 * 32 * 128;
    const int bh = item >> 2, sl = item & 3, b = bh >> 3, h = bh & 7, e = lane & 31, dh = lane >> 5;
    float S[64];
#pragma unroll
    for (int i = 0; i < 64; ++i) S[i] = 0.f;
    for (int t0 = 0; t0 < SEQ; t0 += 32) {
        for (int i = lane; i < 32 * 128; i += 64) { const int tt = i >> 7, d = i & 127; const size_t g = (size_t)(b * SEQ + t0 + tt) * 1024 + h * 128 + d; sq[tt * 128 + d] = bf2f(QH[g]); sf[tt * 128 + d] = expf(LOGF[g]); }
        for (int i = lane; i < 32 * 32; i += 64) { const int tt = i >> 5, ee = i & 31; sv[tt * 32 + ee] = bf2f(VH[(size_t)(b * SEQ + t0 + tt) * 1024 + h * 128 + sl * 32 + ee]); }
        WAVE_SYNC();
        for (int tt = 0; tt < 32; ++tt) {
            const float v = sv[tt * 32 + e]; float o = 0.f;
#pragma unroll
            for (int dd = 0; dd < 64; ++dd) { const float f = sf[tt * 128 + dh * 64 + dd]; S[dd] = f * S[dd] + (1.f - f) * v; o += S[dd] * sq[tt * 128 + dh * 64 + dd]; }
            o += __shfl_xor(o, 32);
            if (lane < 32) O[(size_t)(b * SEQ + t0 + tt) * 1024 + h * 128 + sl * 32 + e] = o;
        }
        WAVE_SYNC();
    }
}
__device__ __forceinline__ void mlscan_item(const Args& a, LAS float* lds, int item, int lane) {
    const float* MQA = (const float*)(a.ws + WS_MQA); const bf16_t* MV = (const bf16_t*)(a.ws + WS_MV); const float* GATES = (const float*)(a.ws + WS_GATES);
    float* NUM = (float*)(a.ws + WS_NUM); float* DEN = (float*)(a.ws + WS_DEN);
    LAS float* sq = lds; LAS float* sk = lds + 32 * 128; LAS float* sv = lds + 2 * 32 * 128; LAS float* sfg = lds + 2 * 32 * 128 + 32 * 32;
    const int bh = item / 9, sl = item % 9, b = bh >> 2, h = bh & 3, e = lane & 31, dh = lane >> 5;
    const float kscale = 0.08838834764831845f;
    float C[64];
#pragma unroll
    for (int i = 0; i < 64; ++i) C[i] = 0.f;
    for (int t0 = 0; t0 < SEQ; t0 += 32) {
        for (int i = lane; i < 32 * 128; i += 64) {
            const int tt = i >> 7, d = i & 127; const size_t row = (size_t)(b * SEQ + t0 + tt);
            const float ig = GATES[row * 8 + h];
            sq[tt * 128 + d] = MQA[row * 1024 + h * 128 + d];
            sk[tt * 128 + d] = MQA[row * 1024 + 512 + h * 128 + d] * kscale * expf(ig);
        }
        for (int i = lane; i < 32 * 32; i += 64) { const int tt = i >> 5, ee = i & 31; const size_t row = (size_t)(b * SEQ + t0 + tt);
            sv[tt * 32 + ee] = (sl < 8) ? bf2f(MV[row * 1024 + h * 256 + sl * 32 + ee]) : (ee == 0 ? 1.f : 0.f); }
        if (lane < 32) sfg[lane] = sigmoid_f(GATES[(size_t)(b * SEQ + t0 + lane) * 8 + 4 + h]);
        WAVE_SYNC();
        for (int tt = 0; tt < 32; ++tt) {
            const float v = sv[tt * 32 + e], f = sfg[tt]; float o = 0.f;
#pragma unroll
            for (int dd = 0; dd < 64; ++dd) { C[dd] = f * C[dd] + sk[tt * 128 + dh * 64 + dd] * v; o += C[dd] * sq[tt * 128 + dh * 64 + dd]; }
            o += __shfl_xor(o, 32);
            const size_t row = (size_t)(b * SEQ + t0 + tt);
            if (lane < 32) { if (sl < 8) NUM[row * 1024 + h * 256 + sl * 32 + e] = o; else if (e == 0) DEN[row * 4 + h] = o; }
        }
        WAVE_SYNC();
    }
}
__device__ __forceinline__ void phase_scans_slow(const Args& a, const Frame& F) {
    if (F.wave < 2) {
        LAS float* lds = (LAS float*)(F.lds + RING_OFF + F.wave * 40960);
        const int slot = F.vcu * 2 + F.wave;
        if (slot < 128) hgscan_item(a, lds, slot, F.lane);
        else if (slot < 128 + 144) mlscan_item(a, lds, slot - 128, F.lane);
    }
}
__device__ __forceinline__ void phase_fins(const Args& a, const Frame& F) {
    const int gw0 = F.vcu * NWAVES + F.wave, NGW = F.G * NWAVES, lane = F.lane;
    {
        const float* O = (const float*)(a.ws + WS_OHG); const bf16_t* GH = (const bf16_t*)(a.ws + WS_GH); bf16_t* YA = (bf16_t*)(a.ws + WS_YA);
        for (int gw = gw0; gw < M_TOK * 8; gw += NGW) {
            const size_t base = (size_t)gw * 128; const int col = (gw & 7) * 128;
            const float x0 = O[base + lane], x1 = O[base + 64 + lane];
            const float ss = wave_sum(x0 * x0 + x1 * x1);
            const float r = 1.f / sqrtf(ss * (1.f / 128.f) + EPS);
            YA[base + lane] = f2bf(x0 * r * a.hg_norm[col + lane] * bf2f(GH[base + lane]));
            YA[base + 64 + lane] = f2bf(x1 * r * a.hg_norm[col + 64 + lane] * bf2f(GH[base + 64 + lane]));
        }
    }
    {
        const float* NUM = (const float*)(a.ws + WS_NUM); const float* DEN = (const float*)(a.ws + WS_DEN); const bf16_t* MO = (const bf16_t*)(a.ws + WS_MO); bf16_t* YB = (bf16_t*)(a.ws + WS_YB);
        for (int gw = gw0; gw < M_TOK * 4; gw += NGW) {
            const size_t base = (size_t)gw * 256; const int col = (gw & 3) * 256;
            const float dn = 1.f / fmaxf(fabsf(DEN[gw]), 1.f);
            float hv[4]; float ss = 0.f;
#pragma unroll
            for (int j = 0; j < 4; ++j) { hv[j] = NUM[base + lane + 64 * j] * dn; ss += hv[j] * hv[j]; }
            ss = wave_sum(ss);
            const float r = 1.f / sqrtf(ss * (1.f / 256.f) + EPS);
#pragma unroll
            for (int j = 0; j < 4; ++j) YB[base + lane + 64 * j] = f2bf(bf2f(MO[base + lane + 64 * j]) * hv[j] * r * a.ml_norm[col + lane + 64 * j]);
        }
    }
}
constexpr int N_PHASES = 12;
__global__ void __launch_bounds__(NWAVES * 64, 2) mk_fwd(Args args) {
    extern __shared__ __attribute__((aligned(16))) unsigned char lds_raw[];
    Frame F;
    F.lds = (LAS unsigned char*)lds_raw;
    F.tid = threadIdx.x; F.lane = F.tid & 63; F.wave = __builtin_amdgcn_readfirstlane(F.tid >> 6);
    F.G = gridDim.x; { const int bx = blockIdx.x; F.vcu = (F.G % 8 == 0) ? (bx % 8) * (F.G / 8) + bx / 8 : bx; }
    volatile LAS unsigned* MISC = (volatile LAS unsigned*)(F.lds + MISC_OFF);
    gu32* ctl = (gu32*)(args.ws + WS_CTL);
    for (int u = F.tid; u < (LDS_BYTES - LDSCTL_OFF) / 4; u += NWAVES * 64) ((LAS unsigned*)(F.lds + LDSCTL_OFF))[u] = 0u;
    __syncthreads();
    const int lo = args.ph_lo, hi = args.ph_hi;
    XcdBarrier bar; bar.bar = (unsigned*)(ctl + CW_BAR) + args.li * XCD_BAR_WORDS; bar.x = 0; bar.st = nullptr;
    if (hi - lo > 1) bar = xcd_barrier_post((unsigned*)(ctl + CW_BAR) + args.li * XCD_BAR_WORDS, MISC + 8);
#define IN(k) (lo <= (k) && (k) < hi)
#define FRESH() do { int t_ = threadIdx.x; asm volatile("" : "+v"(t_)); F.tid = t_; F.lane = t_ & 63; } while (0)
#define SEAM(k) do { if (IN(k) && IN((k) + 1)) xcd_barrier(bar); } while (0)
    unsigned char* ws = args.ws;

    if (IN(0))  { FRESH(); phase_prep(args, F); } SEAM(0);

    if (IN(1)) {
        pg8::Gemm g{(const bf16_t*)(ws + WS_HB), nullptr, (const bf16_t*)(ws + WS_WINT), nullptr, 2048};
        pg8::StaticOrder S; S.init(M_TOK, 11264, F.G, (int)blockIdx.x);
        pg8::EpiInProj E{ws, args.b_in};
        pg8::gemm_phase<pg8::EpiInProj, pg8::StaticOrder, true, true>(F.lds + RING_OFF, g, S, E);
    } SEAM(1);

    if (IN(2))  { FRESH(); phase_mlconv(args, F); } SEAM(2);
    if (IN(3))  { FRESH(); phase_scans_slow(args, F); } SEAM(3);
    if (IN(4))  { FRESH(); phase_fins(args, F); } SEAM(4);

    if (IN(5)) {
        pg8::Gemm g{(const bf16_t*)(ws + WS_YA), (const bf16_t*)(ws + WS_YB), (const bf16_t*)(ws + WS_WA), (const bf16_t*)(ws + WS_WB), 1024};
        pg8::StaticOrder S; S.init(M_TOK, 2048, F.G, (int)blockIdx.x, 2);
        pg8::EpiMerge E{(const bf16_t*)(ws + WS_GA), (const bf16_t*)(ws + WS_GB), (bf16_t*)(ws + WS_MERGED)};
        pg8::gemm_phase<pg8::EpiMerge, pg8::StaticOrder, true, true>(F.lds + RING_OFF, g, S, E);
    } SEAM(5);

    if (IN(6)) {
        pg8::Gemm g{(const bf16_t*)(ws + WS_MERGED), nullptr, (const bf16_t*)(ws + WS_WOUT), nullptr, 2048};
        pg8::StaticOrder S; S.init(M_TOK, 2048, F.G, (int)blockIdx.x);
        pg8::EpiF32 E{(float*)(ws + WS_MIX), 2048};
        pg8::gemm_phase<pg8::EpiF32, pg8::StaticOrder, true, true>(F.lds + RING_OFF, g, S, E);
    } SEAM(6);

    if (IN(7)) {
        FRESH();
        const int gw = F.vcu * NWAVES + F.wave, NGW = F.G * NWAVES;
        for (int m = gw; m < M_TOK; m += NGW) stageF_row(args, m, F.lane);
        phase_ffn_weights(args, F);
    } SEAM(7);

    if (IN(8)) {
        pg8::Gemm g{(const bf16_t*)(ws + WS_H2), nullptr, (const bf16_t*)(ws + WS_WG), nullptr, 2048};
        pg8::StaticOrder S; S.init(M_TOK, 2 * D_FF, F.G, (int)blockIdx.x);
        pg8::EpiSplitBf16 E{(bf16_t*)(ws + WS_GRAW), (bf16_t*)(ws + WS_UP), D_FF / 256, D_FF};
        pg8::gemm_phase<pg8::EpiSplitBf16, pg8::StaticOrder, true, true>(F.lds + RING_OFF, g, S, E);
    } SEAM(8);

    if (IN(9))  { FRESH(); phase_H(args, F); } SEAM(9);

    if (IN(10)) {
        pg8::Gemm g{(const bf16_t*)(ws + WS_UP), nullptr, (const bf16_t*)(ws + WS_WD), nullptr, D_FF};
        pg8::StaticOrder S; S.init(M_TOK, 2048, F.G, (int)blockIdx.x);
        pg8::EpiF32 E{(float*)(ws + WS_FFN), 2048};
        pg8::gemm_phase<pg8::EpiF32, pg8::StaticOrder, true, true>(F.lds + RING_OFF, g, S, E);
    } SEAM(10);

    if (IN(11)) {
        FRESH();
        const int gw = F.vcu * NWAVES + F.wave, NGW = F.G * NWAVES;
        for (int m = gw; m < M_TOK; m += NGW) stageJ_row(args, m, F.lane);
    }
#undef IN
#undef SEAM
}

static int g_grid = 0;
static bool fast_init() {
    if (g_grid == 0) {
        int dev = 0, cus = 0;
        if (hipGetDevice(&dev) != hipSuccess || hipDeviceGetAttribute(&cus, hipDeviceAttributeMultiprocessorCount, dev) != hipSuccess) { g_grid = -1; return false; }
        if (hipFuncSetAttribute((const void*)mk_fwd, hipFuncAttributeMaxDynamicSharedMemorySize, LDS_BYTES) != hipSuccess) { fprintf(stderr, "hipFuncSetAttribute failed\n"); g_grid = -1; return false; }
        int per_cu = 0;
        if (hipOccupancyMaxActiveBlocksPerMultiprocessor(&per_cu, (const void*)mk_fwd, NWAVES * 64, LDS_BYTES) != hipSuccess || per_cu < 1) fprintf(stderr, "note: occupancy query says %d\n", per_cu);
        (void)hipGetLastError();
        g_grid = cus;
    }
    return g_grid > 0;
}
static void fast_launch(void* const* d_in, void* d_out, void* d_ws, hipStream_t stream, int lo, int hi, int li) {
    if (!fast_init()) return;
    Args a{};
    const float** dst = (const float**)&a;
    for (int i = 0; i < 20; ++i) dst[i] = (const float*)d_in[i];
    a.out = (float*)d_out; a.ws = (unsigned char*)d_ws; a.ph_lo = lo; a.ph_hi = hi; a.li = li; a.pad = 0;
    hipLaunchKernelGGL(mk_fwd, dim3(g_grid), dim3(NWAVES * 64), LDS_BYTES, stream, a);
}
struct Ptrs {
    const float *x, *g_mix_pre, *g_mix_post, *g_ffn_pre, *g_ffn_post, *w_in, *b_in, *lb_logits, *hg_norm, *ml_conv_w, *ml_conv_b, *ml_norm, *w_up_a, *w_up_b, *w_out, *ffn_w_gate, *ffn_w_up,
        *ffn_conv_w, *ffn_conv_b, *ffn_w_down;
    float* out; unsigned char* ws;
};
static Ptrs make_ptrs(void* const* d_in, void* d_out, void* d_ws) {
    Ptrs p;
    p.x = (const float*)d_in[0]; p.g_mix_pre = (const float*)d_in[1]; p.g_mix_post = (const float*)d_in[2]; p.g_ffn_pre = (const float*)d_in[3]; p.g_ffn_post = (const float*)d_in[4];
    p.w_in = (const float*)d_in[5]; p.b_in = (const float*)d_in[6]; p.lb_logits = (const float*)d_in[7]; p.hg_norm = (const float*)d_in[8]; p.ml_conv_w = (const float*)d_in[9];
    p.ml_conv_b = (const float*)d_in[10]; p.ml_norm = (const float*)d_in[11]; p.w_up_a = (const float*)d_in[12]; p.w_up_b = (const float*)d_in[13]; p.w_out = (const float*)d_in[14];
    p.ffn_w_gate = (const float*)d_in[15]; p.ffn_w_up = (const float*)d_in[16]; p.ffn_conv_w = (const float*)d_in[17]; p.ffn_conv_b = (const float*)d_in[18]; p.ffn_w_down = (const float*)d_in[19];
    p.out = (float*)d_out; p.ws = (unsigned char*)d_ws;
    return p;
}
#define WSP(T, off) ((T*)(p.ws + (off)))

static void gold_stageA(const Ptrs& p, hipStream_t s) {
    gold::k_lb<<<4, 256, 0, s>>>(p.lb_logits, WSP(float, WS_LB));
    gold::k_prep_rows<<<M_TOK / 4, 256, 0, s>>>(p.x, p.g_mix_pre, p.w_in, p.b_in, WSP(bf16_t, WS_HB), WSP(float, WS_GATES));
}
static void gold_stageB(const Ptrs& p, hipStream_t s) {
    auto seg = [&](int col, int n, gold::Epi e) { e.bias = p.b_in + col; gold::gemm<bf16_t><<<dim3(n / 128, M_TOK / 128), 256, 0, s>>>(WSP(bf16_t, WS_HB), D_MODEL, p.w_in + col, IN_W, D_MODEL, e); };
    const float qs = 0.08838834764831845f;
    seg(C_HGQ, 1024, gold::mk(1, WSP(void, WS_QH), 1024, nullptr, nullptr, nullptr, nullptr, qs));
    seg(C_HGF, 1024, gold::mk(3, WSP(void, WS_LOGF), 1024, nullptr, WSP(float, WS_LB), nullptr, nullptr, 1.f));
    seg(C_HGI, 1024, gold::mk(0, WSP(void, WS_VH), 1024, nullptr, nullptr, nullptr, nullptr, 1.f));
    seg(C_HGG, 1024, gold::mk(1, WSP(void, WS_GH), 1024, nullptr, nullptr, nullptr, nullptr, 1.f));
    seg(C_MQK, 1024, gold::mk(0, WSP(void, WS_MQK), 1024, nullptr, nullptr, nullptr, nullptr, 1.f));
    seg(C_MV, 1024, gold::mk(0, WSP(void, WS_MV), 1024, nullptr, nullptr, nullptr, nullptr, 1.f));
    seg(C_MO, 1024, gold::mk(2, WSP(void, WS_MO), 1024, nullptr, nullptr, nullptr, nullptr, 1.f));
    seg(C_GA, 2048, gold::mk(2, WSP(void, WS_GA), 2048, nullptr, nullptr, nullptr, nullptr, 1.f));
    seg(C_GB, 2048, gold::mk(2, WSP(void, WS_GB), 2048, nullptr, nullptr, nullptr, nullptr, 1.f));
}
static void gold_stageC(const Ptrs& p, hipStream_t s) {
    gold::k_mlconv<<<M_TOK * 1024 / 256, 256, 0, s>>>(WSP(bf16_t, WS_MQK), p.ml_conv_w, p.ml_conv_b, WSP(float, WS_MQA));
    gold::k_hgscan<<<BATCH * HG_HEADS * 4, 64, 0, s>>>(WSP(bf16_t, WS_QH), WSP(float, WS_LOGF), WSP(bf16_t, WS_VH), WSP(float, WS_OHG));
    gold::k_hgfin<<<M_TOK * 8 / 4, 256, 0, s>>>(WSP(float, WS_OHG), WSP(bf16_t, WS_GH), p.hg_norm, WSP(bf16_t, WS_YA));
    gold::k_mlscan<<<BATCH * ML_HEADS * 9, 64, 0, s>>>(WSP(float, WS_MQA), WSP(bf16_t, WS_MV), WSP(float, WS_GATES), WSP(float, WS_NUM), WSP(float, WS_DEN));
    gold::k_mlfin<<<M_TOK * 4 / 4, 256, 0, s>>>(WSP(float, WS_NUM), WSP(float, WS_DEN), WSP(bf16_t, WS_MO), p.ml_norm, WSP(bf16_t, WS_YB));
}
static void gold_stageD(const Ptrs& p, hipStream_t s) {
    gold::gemm<bf16_t><<<dim3(2048 / 128, M_TOK / 128), 256, 0, s>>>(WSP(bf16_t, WS_YA), 1024, p.w_up_a, 2048, 1024, gold::mk(5, WSP(void, WS_TMP), 2048, nullptr, nullptr, WSP(void, WS_GA), nullptr, 1.f));
    gold::gemm<bf16_t><<<dim3(2048 / 128, M_TOK / 128), 256, 0, s>>>(WSP(bf16_t, WS_YB), 1024, p.w_up_b, 2048, 1024, gold::mk(6, WSP(void, WS_MERGED), 2048, nullptr, nullptr, WSP(void, WS_GB), WSP(void, WS_TMP), 1.f));
}
static void gold_stageE(const Ptrs& p, hipStream_t s) {
    gold::gemm<bf16_t><<<dim3(2048 / 128, M_TOK / 128), 256, 0, s>>>(WSP(bf16_t, WS_MERGED), 2048, p.w_out, 2048, 2048, gold::mk(4, WSP(void, WS_MIX), 2048, nullptr, nullptr, nullptr, nullptr, 1.f));
}
static void gold_stageF(const Ptrs& p, hipStream_t s) {
    gold::k_stageF<<<M_TOK / 4, 256, 0, s>>>(p.x, WSP(float, WS_MIX), p.g_mix_post, p.g_ffn_pre, p.out, WSP(bf16_t, WS_H2));
}
static void gold_stageG(const Ptrs& p, hipStream_t s) {
    gold::gemm<bf16_t><<<dim3(D_FF / 128, M_TOK / 128), 256, 0, s>>>(WSP(bf16_t, WS_H2), 2048, p.ffn_w_gate, D_FF, 2048, gold::mk(0, WSP(void, WS_GRAW), D_FF, nullptr, nullptr, nullptr, nullptr, 1.f));
    gold::gemm<bf16_t><<<dim3(D_FF / 128, M_TOK / 128), 256, 0, s>>>(WSP(bf16_t, WS_H2), 2048, p.ffn_w_up, D_FF, 2048, gold::mk(0, WSP(void, WS_UP), D_FF, nullptr, nullptr, nullptr, nullptr, 1.f));
}
static void gold_stageH(const Ptrs& p, hipStream_t s) {
    gold::k_stageH<<<(unsigned)((size_t)M_TOK * D_FF / 256), 256, 0, s>>>(WSP(bf16_t, WS_GRAW), WSP(bf16_t, WS_UP), p.ffn_conv_w, p.ffn_conv_b);
}
static void gold_stageI(const Ptrs& p, hipStream_t s) {
    gold::gemm<bf16_t><<<dim3(2048 / 128, M_TOK / 128), 256, 0, s>>>(WSP(bf16_t, WS_UP), D_FF, p.ffn_w_down, 2048, D_FF, gold::mk(4, WSP(void, WS_FFN), 2048, nullptr, nullptr, nullptr, nullptr, 1.f));
}
static void gold_stageJ(const Ptrs& p, hipStream_t s) {
    gold::k_stageJ<<<M_TOK / 4, 256, 0, s>>>(WSP(float, WS_FFN), p.g_ffn_post, p.out);
}
#ifndef FAST_MASK
#define FAST_MASK 0x3ff
#endif
#ifndef ONE_LAUNCH
#define ONE_LAUNCH 1
#endif
extern "C" void kernel_launch(void* const* d_in, const int* in_sizes, int n_in, void* d_out, int out_size, void* d_ws, size_t ws_size, hipStream_t stream) {
    if (n_in != 20 || out_size != M_TOK * D_MODEL || ws_size < WS_END) { fprintf(stderr, "kernel_launch: unexpected shapes n_in %d out %d ws %zu\n", n_in, out_size, ws_size); return; }
    (void)hipMemsetAsync((char*)d_ws + WS_CTL, 0, 1 * MiB, stream);
#if ONE_LAUNCH
    fast_launch(d_in, d_out, d_ws, stream, 0, N_PHASES, 0);
#else
    const Ptrs p = make_ptrs(d_in, d_out, d_ws);
    const unsigned fm = FAST_MASK;
    static const int ph_lo[10] = {0, 1, 2, 5, 6, 7, 8, 9, 10, 11}, ph_hi[10] = {1, 2, 5, 6, 7, 8, 9, 10, 11, 12};
    typedef void (*gold_fn)(const Ptrs&, hipStream_t);
    static const gold_fn gf[10] = {gold_stageA, gold_stageB, gold_stageC, gold_stageD, gold_stageE, gold_stageF, gold_stageG, gold_stageH, gold_stageI, gold_stageJ};
    int li = 0;
    for (int s = 0; s < 10; ++s) {
        if (s == 0 && !(fm & 1) && (fm & 0x1a)) fast_launch(d_in, d_out, d_ws, stream, 0, 1, li++);
        if (s == 5 && !(fm & 0x20) && (fm & 0x140)) fast_launch(d_in, d_out, d_ws, stream, 7, 8, li++);
        if (fm & (1u << s)) fast_launch(d_in, d_out, d_ws, stream, ph_lo[s], ph_hi[s], li++);
        else gf[s](p, stream);
    }
#endif
}
```

```cpp
#include <hip/hip_runtime.h>
#include <cstdint>
#include <cstdio>

constexpr int D_MODEL = 2048, BATCH = 4, SEQ = 2048, M_TOK = BATCH * SEQ;
constexpr int HG_HEADS = 8, HG_DIM = 128, HG_W = 1024;
constexpr int ML_HEADS = 4, ML_QK = 128, ML_V = 256, ML_QKW = 512, ML_VW = 1024;
constexpr int CHUNK = 64, NCHUNK = SEQ / CHUNK;
constexpr int D_FF = 5632, IN_W = 11272;
constexpr float EPS = 1e-6f;
constexpr int C_HGQ = 0, C_HGF = 1024, C_HGI = 2048, C_HGG = 3072, C_MQK = 4096, C_MV = 5120, C_MO = 6144, C_IG = 7168, C_FG = 7172, C_GA = 7176, C_GB = 9224;

constexpr size_t MiB = 1u << 20;
constexpr size_t WS_CTL = 0;
constexpr size_t WS_LB = 1 * MiB;
constexpr size_t WS_GATES = 1 * MiB + 65536;
constexpr size_t WS_DEN = 1 * MiB + 65536 + 262144;
constexpr size_t WS_WINT = 2 * MiB;
constexpr size_t WS_HB = 46 * MiB;
constexpr size_t WS_WA = 78 * MiB, WS_WB = 82 * MiB, WS_WOUT = 86 * MiB;
constexpr size_t WS_QH = 94 * MiB;
constexpr size_t WS_LOGF = 110 * MiB;
constexpr size_t WS_VH = 142 * MiB;
constexpr size_t WS_GH = 158 * MiB;
constexpr size_t WS_MQK = 174 * MiB;
constexpr size_t WS_MV = 190 * MiB;
constexpr size_t WS_MO = 206 * MiB;
constexpr size_t WS_GA = 222 * MiB, WS_GB = 254 * MiB;
constexpr size_t WS_YA = 286 * MiB, WS_YB = 302 * MiB;
constexpr size_t WS_FREE = 318 * MiB;
constexpr size_t WS_MQA = 2 * MiB;
constexpr size_t WS_OHG = 34 * MiB;
constexpr size_t WS_NUM = 318 * MiB;
constexpr size_t WS_TMP = 94 * MiB;
constexpr size_t WS_MERGED = 158 * MiB;
constexpr size_t WS_MIX = 2 * MiB;
constexpr size_t WS_H2 = 66 * MiB;
constexpr size_t WS_WG = 98 * MiB, WS_WU = 120 * MiB, WS_WD = 142 * MiB;
constexpr size_t WS_GRAW = 164 * MiB;
constexpr size_t WS_UP = 252 * MiB;
constexpr size_t WS_FFN = 2 * MiB;
constexpr size_t WS_END = 340 * MiB;

typedef unsigned short bf16_t;
__device__ __forceinline__ float bf2f(bf16_t h) { return __uint_as_float(((unsigned)h) << 16); }
__device__ __forceinline__ bf16_t f2bf(float f) { unsigned u = __float_as_uint(f); u += 0x7fffu + ((u >> 16) & 1u); return (bf16_t)(u >> 16); }
__device__ __forceinline__ float sigmoid_f(float x) { return 1.f / (1.f + expf(-x)); }
__device__ __forceinline__ float silu_f(float x) { return x / (1.f + expf(-x)); }
__device__ __forceinline__ float gelu_tanh_f(float x) { const float u = 0.7978845608028654f * (x + 0.044715f * x * x * x); return 0.5f * x * (1.f + tanhf(u)); }
__device__ __forceinline__ float wave_sum(float v) {
#pragma unroll
    for (int o = 1; o < 64; o <<= 1) v += __shfl_xor(v, o);
    return v;
}
namespace gold {
struct Epi { void* out; const float* bias; const float* lb; const void* aux; const void* aux2; int mode; int ldo; float scale; int pad; };
static inline Epi mk(int mode, void* out, int ldo, const float* bias, const float* lb, const void* aux, const void* aux2, float scale) { Epi e{}; e.out = out; e.bias = bias; e.lb = lb; e.aux = aux; e.aux2 = aux2; e.mode = mode; e.ldo = ldo; e.scale = scale; e.pad = 0; return e; }
__device__ __forceinline__ void apply(const Epi& e, int m, int n, float v) {
    const size_t idx = (size_t)m * e.ldo + n;
    const float b = e.bias ? e.bias[n] : 0.f;
    switch (e.mode) {
        case 0: ((bf16_t*)e.out)[idx] = f2bf(v + b); break;
        case 1: ((bf16_t*)e.out)[idx] = f2bf(silu_f(v + b) * e.scale); break;
        case 2: ((bf16_t*)e.out)[idx] = f2bf(sigmoid_f(v + b)); break;
        case 3: { const float l = e.lb[n]; ((float*)e.out)[idx] = logf(l + (1.f - l) * sigmoid_f(v + b)); } break;
        case 4: ((float*)e.out)[idx] = v + b; break;
        case 5: ((float*)e.out)[idx] = bf2f(((const bf16_t*)e.aux)[idx]) * v; break;
        default: ((bf16_t*)e.out)[idx] = f2bf(((const float*)e.aux2)[idx] + bf2f(((const bf16_t*)e.aux)[idx]) * v); break;
    }
}
__device__ __forceinline__ float toF(float v) { return v; }
__device__ __forceinline__ float toF(bf16_t v) { return bf2f(v); }

template <typename AT>
__global__ __launch_bounds__(256) void gemm(const AT* __restrict__ A, int lda, const float* __restrict__ W, int ldw, int K, Epi e) {
    __shared__ float As[16][132];
    __shared__ float Ws[16][132];
    const int tid = threadIdx.x, tx = tid & 15, ty = tid >> 4;
    const int m0 = blockIdx.y * 128, n0 = blockIdx.x * 128;
    float acc[8][8];
#pragma unroll
    for (int i = 0; i < 8; ++i)
#pragma unroll
        for (int j = 0; j < 8; ++j) acc[i][j] = 0.f;
    for (int k0 = 0; k0 < K; k0 += 16) {
        {
            const int r = tid >> 1, ko = (tid & 1) * 8;
            const AT* p = A + (size_t)(m0 + r) * lda + k0 + ko;
#pragma unroll
            for (int i = 0; i < 8; ++i) As[ko + i][r] = toF(p[i]);
        }
        {
            const int k = tid >> 4, c = (tid & 15) * 8;
            const float* p = W + (size_t)(k0 + k) * ldw + n0 + c;
#pragma unroll
            for (int i = 0; i < 8; ++i) Ws[k][c + i] = p[i];
        }
        __syncthreads();
#pragma unroll
        for (int k = 0; k < 16; ++k) {
            float a[8], b[8];
#pragma unroll
            for (int i = 0; i < 4; ++i) { a[i] = As[k][ty * 4 + i]; a[4 + i] = As[k][64 + ty * 4 + i]; b[i] = Ws[k][tx * 4 + i]; b[4 + i] = Ws[k][64 + tx * 4 + i]; }
#pragma unroll
            for (int i = 0; i < 8; ++i)
#pragma unroll
                for (int j = 0; j < 8; ++j) acc[i][j] += a[i] * b[j];
        }
        __syncthreads();
    }
#pragma unroll
    for (int i = 0; i < 8; ++i) {
        const int m = m0 + (i < 4 ? ty * 4 + i : 64 + ty * 4 + (i - 4));
#pragma unroll
        for (int j = 0; j < 8; ++j) { const int n = n0 + (j < 4 ? tx * 4 + j : 64 + tx * 4 + (j - 4)); apply(e, m, n, acc[i][j]); }
    }
}

__global__ void k_lb(const float* __restrict__ logits, float* __restrict__ LB) {
    const int c = blockIdx.x * 256 + threadIdx.x;
    if (c < HG_W) { const float a = logits[c], b = logits[HG_W + c], mx = fmaxf(a, b); const float ea = expf(a - mx), eb = expf(b - mx); LB[c] = ea / (ea + eb); }
}

__global__ __launch_bounds__(256) void k_prep_rows(const float* __restrict__ x, const float* __restrict__ gain, const float* __restrict__ w_in, const float* __restrict__ b_in,
                                                   bf16_t* __restrict__ HB, float* __restrict__ GATES) {
    const int wave = threadIdx.x >> 6, lane = threadIdx.x & 63, row = blockIdx.x * 4 + wave;
    const float4* xr = (const float4*)(x + (size_t)row * D_MODEL);
    float4 v[8]; float ss = 0.f;
#pragma unroll
    for (int j = 0; j < 8; ++j) { v[j] = xr[lane + 64 * j]; ss += v[j].x * v[j].x + v[j].y * v[j].y + v[j].z * v[j].z + v[j].w * v[j].w; }
    ss = wave_sum(ss);
    const float r = 1.f / sqrtf(ss * (1.f / D_MODEL) + EPS);
    float g[8];
#pragma unroll
    for (int q = 0; q < 8; ++q) g[q] = 0.f;
#pragma unroll
    for (int j = 0; j < 8; ++j) {
        const int d0 = (lane + 64 * j) * 4;
        const float4 gn = *(const float4*)(gain + d0);
        const float h0 = v[j].x * r * gn.x, h1 = v[j].y * r * gn.y, h2 = v[j].z * r * gn.z, h3 = v[j].w * r * gn.w;
        ushort4 o; o.x = f2bf(h0); o.y = f2bf(h1); o.z = f2bf(h2); o.w = f2bf(h3);
        *(ushort4*)(HB + (size_t)row * D_MODEL + d0) = o;
        const float hh[4] = {h0, h1, h2, h3};
#pragma unroll
        for (int c = 0; c < 4; ++c) {
            const float* wr = w_in + (size_t)(d0 + c) * IN_W + C_IG;
#pragma unroll
            for (int q = 0; q < 8; ++q) g[q] += hh[c] * wr[q];
        }
    }
#pragma unroll
    for (int q = 0; q < 8; ++q) { g[q] = wave_sum(g[q]); }
    if (lane == 0) {
#pragma unroll
        for (int q = 0; q < 8; ++q) GATES[(size_t)row * 8 + q] = g[q] + b_in[C_IG + q];
    }
}

__global__ void k_mlconv(const bf16_t* __restrict__ MQK, const float* __restrict__ cw, const float* __restrict__ cb, float* __restrict__ MQA) {
    const size_t i = (size_t)blockIdx.x * 256 + threadIdx.x;
    const int c = (int)(i & 1023); const int row = (int)(i >> 10); const int t = row % SEQ;
    float a = cb[c];
#pragma unroll
    for (int j = 0; j < 4; ++j) { const int tt = t - 3 + j; if (tt >= 0) a += cw[j * 1024 + c] * bf2f(MQK[(size_t)(row - 3 + j) * 1024 + c]); }
    MQA[i] = silu_f(a);
}

__global__ __launch_bounds__(64) void k_hgscan(const bf16_t* __restrict__ QH, const float* __restrict__ LOGF, const bf16_t* __restrict__ VH, float* __restrict__ O) {
    __shared__ float sq[32][128];
    __shared__ float sf[32][128];
    __shared__ float sv[32][32];
    const int bh = blockIdx.x >> 2, sl = blockIdx.x & 3, b = bh >> 3, h = bh & 7, lane = threadIdx.x, e = lane & 31, dh = lane >> 5;
    float S[64];
#pragma unroll
    for (int i = 0; i < 64; ++i) S[i] = 0.f;
    for (int t0 = 0; t0 < SEQ; t0 += 32) {
        for (int i = lane; i < 32 * 128; i += 64) { const int tt = i >> 7, d = i & 127; const size_t g = (size_t)(b * SEQ + t0 + tt) * 1024 + h * 128 + d; sq[tt][d] = bf2f(QH[g]); sf[tt][d] = expf(LOGF[g]); }
        for (int i = lane; i < 32 * 32; i += 64) { const int tt = i >> 5, ee = i & 31; sv[tt][ee] = bf2f(VH[(size_t)(b * SEQ + t0 + tt) * 1024 + h * 128 + sl * 32 + ee]); }
        __syncthreads();
        for (int tt = 0; tt < 32; ++tt) {
            const float v = sv[tt][e]; float o = 0.f;
#pragma unroll
            for (int dd = 0; dd < 64; ++dd) { const float f = sf[tt][dh * 64 + dd]; S[dd] = f * S[dd] + (1.f - f) * v; o += S[dd] * sq[tt][dh * 64 + dd]; }
            o += __shfl_xor(o, 32);
            if (lane < 32) O[(size_t)(b * SEQ + t0 + tt) * 1024 + h * 128 + sl * 32 + e] = o;
        }
        __syncthreads();
    }
}
__global__ __launch_bounds__(256) void k_hgfin(const float* __restrict__ O, const bf16_t* __restrict__ GH, const float* __restrict__ gain, bf16_t* __restrict__ YA) {
    const int gw = (blockIdx.x * 256 + threadIdx.x) >> 6, lane = threadIdx.x & 63;
    const size_t base = (size_t)gw * 128; const int col = (gw & 7) * 128;
    const float a = O[base + lane], c = O[base + 64 + lane];
    const float ss = wave_sum(a * a + c * c);
    const float r = 1.f / sqrtf(ss * (1.f / 128.f) + EPS);
    YA[base + lane] = f2bf(a * r * gain[col + lane] * bf2f(GH[base + lane]));
    YA[base + 64 + lane] = f2bf(c * r * gain[col + 64 + lane] * bf2f(GH[base + 64 + lane]));
}

__global__ __launch_bounds__(64) void k_mlscan(const float* __restrict__ MQA, const bf16_t* __restrict__ MV, const float* __restrict__ GATES, float* __restrict__ NUM, float* __restrict__ DEN) {
    __shared__ float sq[32][128];
    __shared__ float sk[32][128];
    __shared__ float sv[32][32];
    __shared__ float sfg[32];
    const int bh = blockIdx.x / 9, sl = blockIdx.x % 9, b = bh >> 2, h = bh & 3, lane = threadIdx.x, e = lane & 31, dh = lane >> 5;
    const float kscale = 0.08838834764831845f;
    float C[64];
#pragma unroll
    for (int i = 0; i < 64; ++i) C[i] = 0.f;
    for (int t0 = 0; t0 < SEQ; t0 += 32) {
        for (int i = lane; i < 32 * 128; i += 64) {
            const int tt = i >> 7, d = i & 127; const size_t row = (size_t)(b * SEQ + t0 + tt);
            const float ig = GATES[row * 8 + h];
            sq[tt][d] = MQA[row * 1024 + h * 128 + d];
            sk[tt][d] = MQA[row * 1024 + 512 + h * 128 + d] * kscale * expf(ig);
        }
        for (int i = lane; i < 32 * 32; i += 64) { const int tt = i >> 5, ee = i & 31; const size_t row = (size_t)(b * SEQ + t0 + tt);
            sv[tt][ee] = (sl < 8) ? bf2f(MV[row * 1024 + h * 256 + sl * 32 + ee]) : (ee == 0 ? 1.f : 0.f); }
        if (lane < 32) sfg[lane] = sigmoid_f(GATES[(size_t)(b * SEQ + t0 + lane) * 8 + 4 + h]);
        __syncthreads();
        for (int tt = 0; tt < 32; ++tt) {
            const float v = sv[tt][e], f = sfg[tt]; float o = 0.f;
#pragma unroll
            for (int dd = 0; dd < 64; ++dd) { C[dd] = f * C[dd] + sk[tt][dh * 64 + dd] * v; o += C[dd] * sq[tt][dh * 64 + dd]; }
            o += __shfl_xor(o, 32);
            const size_t row = (size_t)(b * SEQ + t0 + tt);
            if (lane < 32) { if (sl < 8) NUM[row * 1024 + h * 256 + sl * 32 + e] = o; else if (e == 0) DEN[row * 4 + h] = o; }
        }
        __syncthreads();
    }
}
__global__ __launch_bounds__(256) void k_mlfin(const float* __restrict__ NUM, const float* __restrict__ DEN, const bf16_t* __restrict__ MO, const float* __restrict__ gain, bf16_t* __restrict__ YB) {
    const int gw = (blockIdx.x * 256 + threadIdx.x) >> 6, lane = threadIdx.x & 63;
    const size_t base = (size_t)gw * 256; const int col = (gw & 3) * 256;
    const float dn = 1.f / fmaxf(fabsf(DEN[gw]), 1.f);
    float hv[4]; float ss = 0.f;
#pragma unroll
    for (int j = 0; j < 4; ++j) { hv[j] = NUM[base + lane + 64 * j] * dn; ss += hv[j] * hv[j]; }
    ss = wave_sum(ss);
    const float r = 1.f / sqrtf(ss * (1.f / 256.f) + EPS);
#pragma unroll
    for (int j = 0; j < 4; ++j) YB[base + lane + 64 * j] = f2bf(bf2f(MO[base + lane + 64 * j]) * hv[j] * r * gain[col + lane + 64 * j]);
}

__global__ __launch_bounds__(256) void k_stageF(const float* __restrict__ x, const float* __restrict__ MIX, const float* __restrict__ g_post, const float* __restrict__ g_pre2,
                                                float* __restrict__ X1, bf16_t* __restrict__ H2) {
    const int wave = threadIdx.x >> 6, lane = threadIdx.x & 63, row = blockIdx.x * 4 + wave;
    const float4* mr = (const float4*)(MIX + (size_t)row * D_MODEL); const float4* xr = (const float4*)(x + (size_t)row * D_MODEL);
    float4 v[8]; float ss = 0.f;
#pragma unroll
    for (int j = 0; j < 8; ++j) { v[j] = mr[lane + 64 * j]; ss += v[j].x * v[j].x + v[j].y * v[j].y + v[j].z * v[j].z + v[j].w * v[j].w; }
    ss = wave_sum(ss);
    const float r = 1.f / sqrtf(ss * (1.f / D_MODEL) + EPS);
    float s2 = 0.f;
#pragma unroll
    for (int j = 0; j < 8; ++j) {
        const float4 gp = *(const float4*)(g_post + (lane + 64 * j) * 4); const float4 xv = xr[lane + 64 * j];
        v[j].x = xv.x + v[j].x * r * gp.x; v[j].y = xv.y + v[j].y * r * gp.y; v[j].z = xv.z + v[j].z * r * gp.z; v[j].w = xv.w + v[j].w * r * gp.w;
        s2 += v[j].x * v[j].x + v[j].y * v[j].y + v[j].z * v[j].z + v[j].w * v[j].w;
        ((float4*)(X1 + (size_t)row * D_MODEL))[lane + 64 * j] = v[j];
    }
    s2 = wave_sum(s2);
    const float r2 = 1.f / sqrtf(s2 * (1.f / D_MODEL) + EPS);
#pragma unroll
    for (int j = 0; j < 8; ++j) {
        const float4 g2 = *(const float4*)(g_pre2 + (lane + 64 * j) * 4);
        ushort4 o; o.x = f2bf(v[j].x * r2 * g2.x); o.y = f2bf(v[j].y * r2 * g2.y); o.z = f2bf(v[j].z * r2 * g2.z); o.w = f2bf(v[j].w * r2 * g2.w);
        *(ushort4*)(H2 + (size_t)row * D_MODEL + (lane + 64 * j) * 4) = o;
    }
}
__global__ void k_stageH(const bf16_t* __restrict__ GRAW, bf16_t* UPACT, const float* __restrict__ cw, const float* __restrict__ cb) {
    const size_t i = (size_t)blockIdx.x * 256 + threadIdx.x;
    const int c = (int)(i % D_FF); const int row = (int)(i / D_FF); const int t = row % SEQ;
    float a = cb[c];
#pragma unroll
    for (int j = 0; j < 3; ++j) { const int tt = t - 2 + j; if (tt >= 0) a += cw[j * D_FF + c] * bf2f(GRAW[(size_t)(row - 2 + j) * D_FF + c]); }
    UPACT[i] = f2bf(gelu_tanh_f(a) * bf2f(UPACT[i]));
}
__global__ __launch_bounds__(256) void k_stageJ(const float* __restrict__ FFN, const float* __restrict__ g_post, float* OUT) {
    const int wave = threadIdx.x >> 6, lane = threadIdx.x & 63, row = blockIdx.x * 4 + wave;
    const float4* fr = (const float4*)(FFN + (size_t)row * D_MODEL); float4* orow = (float4*)(OUT + (size_t)row * D_MODEL);
    float4 v[8]; float ss = 0.f;
#pragma unroll
    for (int j = 0; j < 8; ++j) { v[j] = fr[lane + 64 * j]; ss += v[j].x * v[j].x + v[j].y * v[j].y + v[j].z * v[j].z + v[j].w * v[j].w; }
    ss = wave_sum(ss);
    const float r = 1.f / sqrtf(ss * (1.f / D_MODEL) + EPS);
#pragma unroll
    for (int j = 0; j < 8; ++j) {
        const float4 gp = *(const float4*)(g_post + (lane + 64 * j) * 4); float4 xv = orow[lane + 64 * j];
        xv.x += v[j].x * r * gp.x; xv.y += v[j].y * r * gp.y; xv.z += v[j].z * r * gp.z; xv.w += v[j].w * r * gp.w;
        orow[lane + 64 * j] = xv;
    }
}
}
namespace pg8 {
#define PG8_LAS __attribute__((address_space(3)))
typedef short bf16x8 __attribute__((ext_vector_type(8)));
typedef float f32x4 __attribute__((ext_vector_type(4)));
typedef float f32x2 __attribute__((ext_vector_type(2)));
typedef unsigned u32x4 __attribute__((ext_vector_type(4)));
typedef unsigned u32x2 __attribute__((ext_vector_type(2)));
constexpr int BM = 256, BK = 64, HALF = 128, HTB = HALF * BK * 2  , STAGE_BYTES = 8 * HTB, NXCD = 8, WGM = 8;

__host__ __device__ __forceinline__ int lds_byte(int r, int c) { const int st = (r >> 4) * 2 + (c >> 5), rr = r & 15, cc = c & 31, ob = rr * 64 + cc * 2; return st * 1024 + (ob ^ (((ob >> 9) & 1) << 5)); }
__host__ __device__ __forceinline__ void stage_rc(int b, int& R, int& C) { const int st = b / 1024, sb = b % 1024, swz = sb ^ (((sb >> 9) & 1) << 5); R = (st >> 1) * 16 + swz / 64; C = (st & 1) * 32 + (swz % 64) / 2; }
__host__ __device__ __forceinline__ int perm32(int rho) { const int n = rho >> 4, i = rho & 15; return 8 * (i >> 2) + 4 * n + (i & 3); }

struct Unit { int pm, pn, sel; };
struct Gemm { const bf16_t* A0; const bf16_t* A1; const bf16_t* B0; const bf16_t* B1; int K; };

struct StaticOrder {
    int nM, nN, nwg, G, c, nsel;
    __host__ __device__ void init(int M, int N, int G_, int c_, int nsel_ = 1) { nM = M / BM; nN = N / BM; nwg = nM * nN; G = G_; c = c_; nsel = nsel_; }
    __host__ __device__ bool next(int i, Unit& u) const {
        const int ti = (nsel == 2) ? (i >> 1) : i;
        const long L = (long)ti * G + c; if (L >= nwg) return false;
        int wgid = (int)L; { const int q = nwg / NXCD, r = nwg % NXCD, xcd = wgid % NXCD, off = wgid / NXCD; wgid = (xcd < r ? xcd * (q + 1) : r * (q + 1) + (xcd - r) * q) + off; }
        const int nig = WGM * nN, gid = wgid / nig, fm = gid * WGM, gsz = (nM - fm) < WGM ? (nM - fm) : WGM;
        u.pm = fm + ((wgid % nig) % gsz); u.pn = (wgid % nig) / gsz; u.sel = (nsel == 2) ? (i & 1) : 0; return true;
    }
};

typedef __bf16 bf16x2_t __attribute__((ext_vector_type(2)));
__device__ __forceinline__ unsigned cvt_pk_bf16(float lo, float hi) { const f32x2 v = {lo, hi}; const bf16x2_t b = __builtin_convertvector(v, bf16x2_t); return __builtin_bit_cast(unsigned, b); }
__device__ __forceinline__ float fast_sigmoid(float x) { return __builtin_amdgcn_rcpf(1.f + __builtin_amdgcn_exp2f(-1.4426950408889634f * x)); }
__device__ __forceinline__ float fast_silu(float x) { return x * fast_sigmoid(x); }
__device__ __forceinline__ u32x4 pack8(const f32x4 a, const f32x4 b) { u32x4 w; w.x = cvt_pk_bf16(a[0], a[1]); w.y = cvt_pk_bf16(a[2], a[3]); w.z = cvt_pk_bf16(b[0], b[1]); w.w = cvt_pk_bf16(b[2], b[3]); return w; }
__device__ __forceinline__ void unpack8(const u32x4 w, f32x4& a, f32x4& b) {
    a[0] = __uint_as_float(w.x << 16); a[1] = __uint_as_float(w.x & 0xffff0000u); a[2] = __uint_as_float(w.y << 16); a[3] = __uint_as_float(w.y & 0xffff0000u);
    b[0] = __uint_as_float(w.z << 16); b[1] = __uint_as_float(w.z & 0xffff0000u); b[2] = __uint_as_float(w.w << 16); b[3] = __uint_as_float(w.w & 0xffff0000u);
}

struct EpiF32 {
    static constexpr bool PERM = false, CHAIN = false;
    float* C; int ldc;
    __device__ __forceinline__ bool operator()(f32x4 (&acc)[2][2][4][2], const Unit& u, int wr, int wc, int fr, int fq) const {
        const int row0 = u.pm * BM + wr * 64 + fr, col0 = u.pn * BM + wc * 32 + 4 * fq;
#pragma unroll
        for (int ai = 0; ai < 2; ++ai)
#pragma unroll
            for (int m = 0; m < 4; ++m) { float* rowp = C + (size_t)(row0 + ai * HALF + m * 16) * ldc + col0;
#pragma unroll
                for (int bj = 0; bj < 2; ++bj)
#pragma unroll
                    for (int n = 0; n < 2; ++n) *(f32x4*)(rowp + bj * HALF + n * 16) = acc[ai][bj][m][n]; }
        return false;
    }
};
struct EpiSplitBf16 {
    static constexpr bool PERM = true, CHAIN = false;
    bf16_t* O0; bf16_t* O1; int ntile0; int ldc;
    __device__ __forceinline__ bool operator()(f32x4 (&acc)[2][2][4][2], const Unit& u, int wr, int wc, int fr, int fq) const {
        const int row0 = u.pm * BM + wr * 64 + fr; const bool second = u.pn >= ntile0; bf16_t* base = second ? O1 : O0;
        const int col0 = (second ? u.pn - ntile0 : u.pn) * BM + wc * 32 + 8 * fq;
#pragma unroll
        for (int ai = 0; ai < 2; ++ai)
#pragma unroll
            for (int m = 0; m < 4; ++m) { bf16_t* rowp = base + (size_t)(row0 + ai * HALF + m * 16) * ldc + col0;
#pragma unroll
                for (int bj = 0; bj < 2; ++bj) *(u32x4*)(rowp + bj * HALF) = pack8(acc[ai][bj][m][0], acc[ai][bj][m][1]); }
        return false;
    }
};
struct EpiInProj {
    static constexpr bool PERM = true, CHAIN = false;
    unsigned char* ws; const float* b_in;
    __device__ __forceinline__ bool operator()(f32x4 (&acc)[2][2][4][2], const Unit& u, int wr, int wc, int fr, int fq) const {
        float* LOGF = (float*)(ws + WS_LOGF); const float* LB = (const float*)(ws + WS_LB);
        const int pn = u.pn; const int seg = pn < 28 ? (pn >> 2) : (pn < 36 ? 7 : 8);
        const int ctile = pn < 28 ? (pn & 3) : (pn < 36 ? pn - 28 : pn - 36);
        const int ld = seg < 7 ? 1024 : 2048;
        const int cseg0 = ctile * BM + wc * 32 + 8 * fq;
        const int borig0 = pn * BM + wc * 32 + 8 * fq + (pn >= 28 ? 8 : 0);
        const int row0 = u.pm * BM + wr * 64 + fr;
        const size_t oboff = seg == 0 ? WS_QH : seg == 2 ? WS_VH : seg == 3 ? WS_GH : seg == 4 ? WS_MQK : seg == 5 ? WS_MV : seg == 6 ? WS_MO : seg == 7 ? WS_GA : WS_GB;
        bf16_t* ob = (bf16_t*)(ws + oboff);
#pragma unroll
        for (int bj = 0; bj < 2; ++bj) {
            const f32x4 b0 = *(const f32x4*)(b_in + borig0 + bj * HALF), b1 = *(const f32x4*)(b_in + borig0 + bj * HALF + 4);
            f32x4 l0 = (f32x4){0.f, 0.f, 0.f, 0.f}, l1 = l0;
            if (seg == 1) { l0 = *(const f32x4*)(LB + cseg0 + bj * HALF); l1 = *(const f32x4*)(LB + cseg0 + bj * HALF + 4); }
#pragma unroll
            for (int ai = 0; ai < 2; ++ai)
#pragma unroll
                for (int m = 0; m < 4; ++m) {
                    f32x4 v0 = acc[ai][bj][m][0] + b0, v1 = acc[ai][bj][m][1] + b1;
                    const size_t off = (size_t)(row0 + ai * HALF + m * 16) * ld + cseg0 + bj * HALF;
                    if (seg == 1) {
#pragma unroll
                        for (int j = 0; j < 4; ++j) { v0[j] = __logf(l0[j] + (1.f - l0[j]) * fast_sigmoid(v0[j])); v1[j] = __logf(l1[j] + (1.f - l1[j]) * fast_sigmoid(v1[j])); }
                        *(f32x4*)(LOGF + off) = v0; *(f32x4*)(LOGF + off + 4) = v1;
                    } else {
                        if (seg == 0) {
#pragma unroll
                            for (int j = 0; j < 4; ++j) { v0[j] = fast_silu(v0[j]) * 0.08838834764831845f; v1[j] = fast_silu(v1[j]) * 0.08838834764831845f; }
                        } else if (seg == 3) {
#pragma unroll
                            for (int j = 0; j < 4; ++j) { v0[j] = fast_silu(v0[j]); v1[j] = fast_silu(v1[j]); }
                        } else if (seg >= 6) {
#pragma unroll
                            for (int j = 0; j < 4; ++j) { v0[j] = fast_sigmoid(v0[j]); v1[j] = fast_sigmoid(v1[j]); }
                        }
                        *(u32x4*)(ob + off) = pack8(v0, v1);
                    }
                }
        }
        return false;
    }
};
struct EpiMerge {
    static constexpr bool PERM = true, CHAIN = true;
    const bf16_t* GA; const bf16_t* GB; bf16_t* OUT;
    __device__ __forceinline__ bool operator()(f32x4 (&acc)[2][2][4][2], const Unit& u, int wr, int wc, int fr, int fq) const {
        const int row0 = u.pm * BM + wr * 64 + fr, col0 = u.pn * BM + wc * 32 + 8 * fq;
#pragma unroll
        for (int ai = 0; ai < 2; ++ai)
#pragma unroll
            for (int m = 0; m < 4; ++m)
#pragma unroll
                for (int bj = 0; bj < 2; ++bj) {
                    const size_t off = (size_t)(row0 + ai * HALF + m * 16) * 2048 + col0 + bj * HALF;
                    f32x4 gb0, gb1; unpack8(*(const u32x4*)(GB + off), gb0, gb1);
                    if (u.sel == 0) {
                        f32x4 ga0, ga1; unpack8(*(const u32x4*)(GA + off), ga0, ga1);
#pragma unroll
                        for (int j = 0; j < 4; ++j) { acc[ai][bj][m][0][j] *= ga0[j] * __builtin_amdgcn_rcpf(fmaxf(gb0[j], 1e-30f)); acc[ai][bj][m][1][j] *= ga1[j] * __builtin_amdgcn_rcpf(fmaxf(gb1[j], 1e-30f)); }
                    } else {
                        *(u32x4*)(OUT + off) = pack8(acc[ai][bj][m][0] * gb0, acc[ai][bj][m][1] * gb1);
                    }
                }
        return u.sel == 0;
    }
};

template <class Epi, class Sched, bool ALIGN_EPI = false, bool SP2 = false>
__device__ __forceinline__ void gemm_phase(PG8_LAS unsigned char* lds, const Gemm g, const Sched& S, const Epi& E) {
    int tid_ = threadIdx.x; asm volatile("" : "+v"(tid_));
    const int tid = tid_, wid = __builtin_amdgcn_readfirstlane(tid >> 6), lane = tid & 63, wr = wid >> 2, wc = wid & 3, fr = lane & 15, fq = lane >> 4;
    const int K = g.K, nt = K / BK;
    unsigned voffA[2], voffB[2];
#pragma unroll
    for (int i = 0; i < 2; ++i) { int R, C; stage_rc(tid * 16 + i * 8192, R, C); const int Rb = Epi::PERM ? ((R & ~31) + perm32(R & 31)) : R;
        voffA[i] = (unsigned)(R * K + C) * 2u; voffB[i] = (unsigned)(Rb * K + C) * 2u; }
    const size_t kstep = (size_t)(BK * 2);
    const size_t hstep = (size_t)HALF * K * 2;
    const size_t tstep = 2 * hstep;
    const unsigned ldsw = (unsigned)wid * 1024u;
    const int aoff = lds_byte(wr * 64 + fr, fq * 8), boff = lds_byte(wc * 32 + fr, fq * 8);
#define PG8_SA(b, h) (((b) * 2 + (h)) * HTB)
#define PG8_SB(b, h) ((4 + (b) * 2 + (h)) * HTB)
#define PG8_STAGE(bufoff, gbase, voff) do { _Pragma("unroll") for (int _i = 0; _i < 2; ++_i) \
        __builtin_amdgcn_global_load_lds((const unsigned*)((const char*)(gbase) + (voff)[_i]), (PG8_LAS unsigned*)(lds + (bufoff) + ldsw + _i * 8192), 16, 0, 0); } while (0)
#define PG8_LDA(dst, b, h) do { _Pragma("unroll") for (int m = 0; m < 4; ++m) _Pragma("unroll") for (int k = 0; k < 2; ++k) dst[m][k] = *(const PG8_LAS bf16x8*)(lds + PG8_SA(b, h) + aoff + m * 2048 + k * 1024); } while (0)
#define PG8_LDB(dst, b, h) do { _Pragma("unroll") for (int n = 0; n < 2; ++n) _Pragma("unroll") for (int k = 0; k < 2; ++k) dst[n][k] = *(const PG8_LAS bf16x8*)(lds + PG8_SB(b, h) + boff + n * 2048 + k * 1024); } while (0)
#define PG8_MMA(ai, bj, At, Bt) do { __builtin_amdgcn_s_setprio(1); _Pragma("unroll") for (int m = 0; m < 4; ++m) _Pragma("unroll") for (int n = 0; n < 2; ++n) _Pragma("unroll") for (int k = 0; k < 2; ++k) \
        acc[ai][bj][m][n] = __builtin_amdgcn_mfma_f32_16x16x32_bf16(Bt[n][k], At[m][k], acc[ai][bj][m][n], 0, 0, 0); __builtin_amdgcn_s_setprio(0); } while (0)
#define PG8_WAIT_V(n) asm volatile("s_waitcnt vmcnt(" #n ")" ::: "memory")
#define PG8_WAIT_L(n) asm volatile("s_waitcnt lgkmcnt(" #n ")" ::: "memory")
#define PG8_BAR __builtin_amdgcn_s_barrier()
#define PG8_SCHED __builtin_amdgcn_sched_barrier(0)
    Unit cur, nxt; int ui = 0;
    if (!S.next(0, cur)) return;
    f32x4 acc[2][2][4][2];
#pragma unroll
    for (int a = 0; a < 2; ++a)
#pragma unroll
        for (int b = 0; b < 2; ++b)
#pragma unroll
            for (int m = 0; m < 4; ++m)
#pragma unroll
                for (int n = 0; n < 2; ++n) acc[a][b][m][n] = (f32x4){0.f, 0.f, 0.f, 0.f};
    bf16x8 At[4][2], B0[2][2], B1[2][2];
    const char* cA = (const char*)(cur.sel ? g.A1 : g.A0) + (size_t)cur.pm * tstep; const char* cB = (const char*)(cur.sel ? g.B1 : g.B0) + (size_t)cur.pn * tstep;
    if constexpr (SP2) {
        PG8_STAGE(PG8_SB(0, 0), cB, voffB); PG8_STAGE(PG8_SB(0, 1), cB + hstep, voffB); PG8_STAGE(PG8_SA(0, 0), cA, voffA); PG8_STAGE(PG8_SA(0, 1), cA + hstep, voffA);
        if (wr == 1) PG8_BAR;
        PG8_WAIT_V(2); PG8_BAR;
        PG8_STAGE(PG8_SB(1, 0), cB + kstep, voffB); PG8_STAGE(PG8_SA(1, 0), cA + kstep, voffA); PG8_STAGE(PG8_SB(1, 1), cB + hstep + kstep, voffB);
        PG8_WAIT_V(6); PG8_BAR;
    } else {
        PG8_STAGE(PG8_SB(0, 0), cB, voffB); PG8_STAGE(PG8_SA(0, 0), cA, voffA); PG8_STAGE(PG8_SB(0, 1), cB + hstep, voffB); PG8_STAGE(PG8_SA(0, 1), cA + hstep, voffA);
        if (wr == 1) PG8_BAR;
        PG8_WAIT_V(4); PG8_BAR;
        PG8_STAGE(PG8_SB(1, 0), cB + kstep, voffB); PG8_STAGE(PG8_SA(1, 0), cA + kstep, voffA); PG8_STAGE(PG8_SB(1, 1), cB + hstep + kstep, voffB);
        PG8_WAIT_V(6); PG8_BAR;
    }
    for (;;) {
        const bool has_next = S.next(ui + 1, nxt);
        const char* nA = has_next ? (const char*)(nxt.sel ? g.A1 : g.A0) + (size_t)nxt.pm * tstep : cA; const char* nB = has_next ? (const char*)(nxt.sel ? g.B1 : g.B0) + (size_t)nxt.pn * tstep : cB;
        for (int t = 0; t < nt; t += 2) {
            const bool last = (t == nt - 2);
            const char* a1 = cA + (size_t)(t + 1) * kstep;
            const char* a2 = last ? nA : cA + (size_t)(t + 2) * kstep; const char* b2 = last ? nB : cB + (size_t)(t + 2) * kstep;
            const char* a3 = a2 + kstep; const char* b3 = b2 + kstep;
            if constexpr (SP2) {
            PG8_LDB(B0, 0, 0); PG8_LDB(B1, 0, 1); PG8_SCHED; PG8_LDA(At, 0, 0); PG8_STAGE(PG8_SA(1, 1), a1 + hstep, voffA);
            PG8_WAIT_V(8); PG8_WAIT_L(0); PG8_BAR; PG8_MMA(0, 0, At, B0); PG8_MMA(0, 1, At, B1); PG8_BAR; PG8_SCHED;
            PG8_LDA(At, 0, 1); PG8_STAGE(PG8_SB(0, 0), b2, voffB); PG8_STAGE(PG8_SB(0, 1), b2 + hstep, voffB); PG8_STAGE(PG8_SA(0, 0), a2, voffA);
            PG8_WAIT_V(8); PG8_WAIT_L(0); PG8_BAR; PG8_MMA(1, 0, At, B0); PG8_MMA(1, 1, At, B1); PG8_BAR; PG8_SCHED;
            PG8_LDB(B0, 1, 0); PG8_LDB(B1, 1, 1); PG8_SCHED; PG8_LDA(At, 1, 0); PG8_STAGE(PG8_SA(0, 1), a2 + hstep, voffA);
            PG8_WAIT_V(8); PG8_WAIT_L(0); PG8_BAR; PG8_MMA(0, 0, At, B0); PG8_MMA(0, 1, At, B1); PG8_BAR; PG8_SCHED;
            PG8_LDA(At, 1, 1); PG8_STAGE(PG8_SB(1, 0), b3, voffB); PG8_STAGE(PG8_SB(1, 1), b3 + hstep, voffB); PG8_STAGE(PG8_SA(1, 0), a3, voffA);
            PG8_WAIT_V(8); PG8_WAIT_L(0); PG8_BAR; PG8_MMA(1, 0, At, B0); PG8_MMA(1, 1, At, B1); PG8_BAR; PG8_SCHED;
            } else {
            PG8_LDB(B0, 0, 0); PG8_SCHED; PG8_LDA(At, 0, 0); PG8_STAGE(PG8_SA(1, 1), a1 + hstep, voffA);
            PG8_WAIT_L(8); PG8_BAR; PG8_WAIT_L(0); PG8_MMA(0, 0, At, B0); PG8_BAR; PG8_SCHED;
            PG8_LDB(B1, 0, 1); PG8_STAGE(PG8_SB(0, 0), b2, voffB);
            PG8_BAR; PG8_WAIT_L(0); PG8_MMA(0, 1, At, B1); PG8_BAR;
            PG8_LDA(At, 0, 1); PG8_STAGE(PG8_SA(0, 0), a2, voffA);
            PG8_BAR; PG8_WAIT_L(0); PG8_MMA(1, 0, At, B0); PG8_BAR; PG8_SCHED;
            PG8_STAGE(PG8_SB(0, 1), b2 + hstep, voffB);
            PG8_WAIT_V(6); PG8_BAR; PG8_MMA(1, 1, At, B1); PG8_BAR;
            PG8_LDB(B0, 1, 0); PG8_SCHED; PG8_LDA(At, 1, 0); PG8_STAGE(PG8_SA(0, 1), a2 + hstep, voffA);
            PG8_WAIT_L(8); PG8_BAR; PG8_WAIT_L(0); PG8_MMA(0, 0, At, B0); PG8_BAR; PG8_SCHED;
            PG8_LDB(B1, 1, 1); PG8_STAGE(PG8_SB(1, 0), b3, voffB);
            PG8_BAR; PG8_WAIT_L(0); PG8_MMA(0, 1, At, B1); PG8_BAR;
            PG8_LDA(At, 1, 1); PG8_STAGE(PG8_SA(1, 0), a3, voffA);
            PG8_BAR; PG8_WAIT_L(0); PG8_MMA(1, 0, At, B0); PG8_BAR; PG8_SCHED;
            PG8_STAGE(PG8_SB(1, 1), b3 + hstep, voffB);
            PG8_WAIT_V(6); PG8_BAR; PG8_MMA(1, 1, At, B1); PG8_BAR;
            }
        }
        if constexpr (ALIGN_EPI) { if (wr == 0) PG8_BAR; }
        const bool keep = E(acc, cur, wr, wc, fr, fq);
        if (!has_next) break;
        if (!(Epi::CHAIN && keep)) {
#pragma unroll
            for (int a = 0; a < 2; ++a)
#pragma unroll
                for (int b = 0; b < 2; ++b)
#pragma unroll
                    for (int m = 0; m < 4; ++m)
#pragma unroll
                        for (int n = 0; n < 2; ++n) acc[a][b][m][n] = (f32x4){0.f, 0.f, 0.f, 0.f};
        }
        cur = nxt; cA = nA; cB = nB; ++ui;
        if constexpr (ALIGN_EPI) { if (wr == 1) PG8_BAR; }
    }
    PG8_WAIT_V(0);
    if constexpr (!ALIGN_EPI) { if (wr == 0) PG8_BAR; }
    PG8_BAR;
#undef PG8_SA
#undef PG8_SB
#undef PG8_STAGE
#undef PG8_LDA
#undef PG8_LDB
#undef PG8_MMA
#undef PG8_WAIT_V
#undef PG8_WAIT_L
#undef PG8_BAR
#undef PG8_SCHED
}
}
constexpr int NWAVES = 8;
constexpr int RING_OFF = 0, RING_BYTES = 131072;
constexpr int LDSCTL_OFF = RING_BYTES, MISC_OFF = LDSCTL_OFF + 320;
constexpr int LDS_BYTES = 147456;
constexpr int CW_TMO = 0, CW_CODE = 1;
constexpr int CW_BAR = 4096;
#define GAS __attribute__((address_space(1)))
#define LAS __attribute__((address_space(3)))
typedef unsigned v4u __attribute__((ext_vector_type(4)));
typedef float f32x4 __attribute__((ext_vector_type(4)));
typedef GAS unsigned gu32;
#define RLX_AGENT __ATOMIC_RELAXED, __HIP_MEMORY_SCOPE_AGENT
#define LDS_WAIT() asm volatile("s_waitcnt lgkmcnt(0)" ::: "memory")
#define VM_WAIT() asm volatile("s_waitcnt vmcnt(0)" ::: "memory")
__device__ __forceinline__ unsigned pk2(float lo, float hi) { return (unsigned)f2bf(lo) | ((unsigned)f2bf(hi) << 16); }

#define XB_TMO      128
#define XB_XCNT(j)  (256  + 64 * (j))
#define XB_XSUB(j)  (1280 + 64 * (j))
#define XB_XGEN(j)  (2304 + 64 * (j))
#define XB_TOP      3328
#define XB_TOPGEN   3392
#define XCD_BAR_WORDS 3456
#define XB_SPIN_CAP (1u << 18)
__device__ __forceinline__ unsigned xb_ld(unsigned* p)              { return __hip_atomic_load(p, __ATOMIC_RELAXED, __HIP_MEMORY_SCOPE_AGENT); }
__device__ __forceinline__ unsigned xb_add(unsigned* p, unsigned v) { return __hip_atomic_fetch_add(p, v, __ATOMIC_RELAXED, __HIP_MEMORY_SCOPE_AGENT); }
__device__ __forceinline__ unsigned xb_xcc_id() { return (unsigned)__builtin_amdgcn_s_getreg((3 << 11) | 20) & 0xFu; }
#define XB_SPIN(cond, bar) do { unsigned _sp = 0; while (cond) { __builtin_amdgcn_s_sleep(1); \
    if ((++_sp & 255u) == 0u) { if (xb_ld(&(bar)[XB_TMO])) break; if (_sp > XB_SPIN_CAP) { atomicAdd(&(bar)[XB_TMO], 1u); break; } } } } while (0)
struct XcdBarrier { unsigned* bar; unsigned x; volatile LAS unsigned* st; };
__device__ __forceinline__ XcdBarrier xcd_barrier_post(unsigned* bar, volatile LAS unsigned* st) {
    XcdBarrier b; b.bar = bar; b.x = xb_xcc_id(); b.st = st;
    if (threadIdx.x == 0) (void)xb_add(&bar[XB_XCNT(b.x)], 1u);
    return b;
}
__device__ __forceinline__ void xcd_barrier_complete(unsigned* bar, unsigned x, unsigned& nloc, unsigned& nx) {
    const unsigned G = gridDim.x * gridDim.y * gridDim.z;
    unsigned sum, cnt, mine, sp = 0u;
    for (;;) {
        sum = 0u; cnt = 0u; mine = 0u;
#pragma unroll
        for (unsigned j = 0; j < 16; ++j) { const unsigned c = xb_ld(&bar[XB_XCNT(j)]); sum += c; cnt += (c > 0u) ? 1u : 0u; mine = (j == x) ? c : mine; }
        if (sum == G) break;
        __builtin_amdgcn_s_sleep(1);
        if ((++sp & 255u) == 0u) { if (xb_ld(&bar[XB_TMO])) break; if (sp > XB_SPIN_CAP) { atomicAdd(&bar[XB_TMO], 1u); break; } }
    }
    nloc = mine > 0u ? mine : 1u; nx = cnt > 0u ? cnt : 1u;
}
__device__ __forceinline__ void xcd_barrier(const XcdBarrier& b) {
    asm volatile("s_waitcnt vmcnt(0)" ::: "memory");
    __syncthreads();
    if (threadIdx.x == 0) {
        unsigned* bar = b.bar;
        __builtin_amdgcn_s_waitcnt(0);
        unsigned nloc = b.st[0], nx = b.st[1];
        if (nloc == 0u) { xcd_barrier_complete(bar, b.x, nloc, nx); b.st[0] = nloc; b.st[1] = nx; }
        const unsigned old = xb_add(&bar[XB_XSUB(b.x)], 1u);
        const unsigned gen = old / nloc;
        if (old + 1u == (gen + 1u) * nloc) {
            __builtin_amdgcn_fence(__ATOMIC_RELEASE, "agent");
            asm volatile("s_waitcnt vmcnt(0)" ::: "memory");
            const unsigned og = xb_add(&bar[XB_TOP], 1u);
            const unsigned tg = og / nx;
            if (og + 1u == (tg + 1u) * nx) xb_add(&bar[XB_TOPGEN], 1u);
            else XB_SPIN(xb_ld(&bar[XB_TOPGEN]) == tg, bar);
            __builtin_amdgcn_fence(__ATOMIC_ACQUIRE, "agent");
            xb_add(&bar[XB_XGEN(b.x)], 1u);
            asm volatile("s_waitcnt vmcnt(0)" ::: "memory");
        } else {
            XB_SPIN(xb_ld(&bar[XB_XGEN(b.x)]) == gen, bar);
            __builtin_amdgcn_fence(__ATOMIC_ACQUIRE, "agent");
            asm volatile("s_waitcnt vmcnt(0)" ::: "memory");
        }
    }
    __syncthreads();
}

struct Args {
    const float *x, *g_mix_pre, *g_mix_post, *g_ffn_pre, *g_ffn_post, *w_in, *b_in, *lb_logits, *hg_norm, *ml_conv_w, *ml_conv_b, *ml_norm, *w_up_a, *w_up_b, *w_out, *ffn_w_gate, *ffn_w_up,
        *ffn_conv_w, *ffn_conv_b, *ffn_w_down;
    float* out; unsigned char* ws;
    int ph_lo, ph_hi, li, pad;
};
struct Frame { LAS unsigned char* lds; int tid, lane, wave, vcu, G; };

__device__ __forceinline__ void transpose_item(const float* W, int K, int ldw, int nblk, int gap_at, bf16_t* WT, LAS float* scr, int item, int lane) {
    const int kb = item / nblk, nb = item % nblk, k0 = 64 * kb, n0 = 32 * nb, ns = n0 + (n0 >= gap_at ? 8 : 0);
#pragma unroll 8
    for (int i = 0; i < 32; ++i) { const int kk = 2 * i + (lane >> 5); scr[kk * 33 + (lane & 31)] = W[(size_t)(k0 + kk) * ldw + ns + (lane & 31)]; }
    LDS_WAIT(); asm volatile("" ::: "memory");
    const int c = lane & 7;
#pragma unroll
    for (int j = 0; j < 4; ++j) { const int n = (lane >> 3) + 8 * j; const LAS float* s = scr + (8 * c) * 33 + n;
        v4u o; o.x = pk2(s[0 * 33], s[1 * 33]); o.y = pk2(s[2 * 33], s[3 * 33]); o.z = pk2(s[4 * 33], s[5 * 33]); o.w = pk2(s[6 * 33], s[7 * 33]);
        *(GAS v4u*)(WT + (size_t)(n0 + n) * K + k0 + 8 * c) = o; }
    LDS_WAIT(); asm volatile("" ::: "memory");
}
__device__ __forceinline__ void prep_row(const Args& a, const LAS float* w8t, int row, int lane) {
    asm volatile("" ::: "memory");
    const float4* xr = (const float4*)(a.x + (size_t)row * D_MODEL);
    bf16_t* HB = (bf16_t*)(a.ws + WS_HB); float* GATES = (float*)(a.ws + WS_GATES);
    float4 v[8]; float ss = 0.f;
#pragma unroll
    for (int j = 0; j < 8; ++j) { v[j] = xr[lane + 64 * j]; ss += v[j].x * v[j].x + v[j].y * v[j].y + v[j].z * v[j].z + v[j].w * v[j].w; }
    ss = wave_sum(ss);
    const float r = 1.f / sqrtf(ss * (1.f / D_MODEL) + EPS);
    float g[8];
#pragma unroll
    for (int q = 0; q < 8; ++q) g[q] = 0.f;
#pragma unroll
    for (int j = 0; j < 8; ++j) {
        const int d0 = (lane + 64 * j) * 4;
        const float4 gn = *(const float4*)(a.g_mix_pre + d0);
        const float h0 = v[j].x * r * gn.x, h1 = v[j].y * r * gn.y, h2 = v[j].z * r * gn.z, h3 = v[j].w * r * gn.w;
        uint2 o; o.x = pk2(h0, h1); o.y = pk2(h2, h3);
        *(uint2*)(HB + (size_t)row * D_MODEL + d0) = o;
#pragma unroll
        for (int q = 0; q < 8; ++q) { const f32x4 w = *(const LAS f32x4*)(w8t + q * 2048 + d0); g[q] += (h0 * w[0] + h1 * w[1]) + (h2 * w[2] + h3 * w[3]); }
        asm volatile("" ::: "memory");
    }
#pragma unroll
    for (int q = 0; q < 8; ++q) g[q] = wave_sum(g[q]);
    if (lane == 0) {
#pragma unroll
        for (int q = 0; q < 8; ++q) GATES[(size_t)row * 8 + q] = g[q] + a.b_in[C_IG + q];
    }
}
__device__ __forceinline__ void phase_prep(const Args& a, const Frame& F) {
    LAS float* scr = (LAS float*)(F.lds + RING_OFF + F.wave * 16384);
    const int gw = F.vcu * NWAVES + F.wave, NGW = F.G * NWAVES;
    constexpr int I_IN = (2048 / 64) * (11264 / 32), I_A = (1024 / 64) * (2048 / 32), I_O = (2048 / 64) * (2048 / 32);
    constexpr int NITEMS = I_IN + 2 * I_A + I_O;
    for (int it = gw; it < NITEMS; it += NGW) {
        int r = it;
        if (r < I_IN) { transpose_item(a.w_in, 2048, IN_W, 11264 / 32, 7168, (bf16_t*)(a.ws + WS_WINT), scr, r, F.lane); continue; } r -= I_IN;
        if (r < I_A) { transpose_item(a.w_up_a, 1024, 2048, 2048 / 32, 1 << 30, (bf16_t*)(a.ws + WS_WA), scr, r, F.lane); continue; } r -= I_A;
        if (r < I_A) { transpose_item(a.w_up_b, 1024, 2048, 2048 / 32, 1 << 30, (bf16_t*)(a.ws + WS_WB), scr, r, F.lane); continue; } r -= I_A;
        transpose_item(a.w_out, 2048, 2048, 2048 / 32, 1 << 30, (bf16_t*)(a.ws + WS_WOUT), scr, r, F.lane);
    }
    __syncthreads();
    LAS float* w8t = (LAS float*)(F.lds + RING_OFF);
    for (int d = F.tid; d < D_MODEL; d += NWAVES * 64) { const float4* wr = (const float4*)(a.w_in + (size_t)d * IN_W + C_IG); const float4 w0 = wr[0], w1 = wr[1];
        w8t[0 * 2048 + d] = w0.x; w8t[1 * 2048 + d] = w0.y; w8t[2 * 2048 + d] = w0.z; w8t[3 * 2048 + d] = w0.w; w8t[4 * 2048 + d] = w1.x; w8t[5 * 2048 + d] = w1.y; w8t[6 * 2048 + d] = w1.z; w8t[7 * 2048 + d] = w1.w; }
    __syncthreads();
    for (int m = gw; m < M_TOK; m += NGW) prep_row(a, w8t, m, F.lane);
    if (gw < 16) { const int c = gw * 64 + F.lane; const float l0 = a.lb_logits[c], l1 = a.lb_logits[HG_W + c], mx = fmaxf(l0, l1); const float e0 = expf(l0 - mx), e1 = expf(l1 - mx); ((float*)(a.ws + WS_LB))[c] = e0 / (e0 + e1); }
}
__device__ __forceinline__ void phase_ffn_weights(const Args& a, const Frame& F) {
    LAS float* scr = (LAS float*)(F.lds + RING_OFF + F.wave * 16384);
    const int gw = F.vcu * NWAVES + F.wave, NGW = F.G * NWAVES;
    constexpr int I_G = (2048 / 64) * (D_FF / 32), I_D = (D_FF / 64) * (2048 / 32);
    for (int it = gw; it < 2 * I_G + I_D; it += NGW) {
        int r = it;
        if (r < I_G) { transpose_item(a.ffn_w_gate, 2048, D_FF, D_FF / 32, 1 << 30, (bf16_t*)(a.ws + WS_WG), scr, r, F.lane); continue; } r -= I_G;
        if (r < I_G) { transpose_item(a.ffn_w_up, 2048, D_FF, D_FF / 32, 1 << 30, (bf16_t*)(a.ws + WS_WU), scr, r, F.lane); continue; } r -= I_G;
        transpose_item(a.ffn_w_down, D_FF, 2048, 2048 / 32, 1 << 30, (bf16_t*)(a.ws + WS_WD), scr, r, F.lane);
    }
}

__device__ __forceinline__ void stageF_row(const Args& a, int row, int lane) {
    const float4* mr = (const float4*)((const float*)(a.ws + WS_MIX) + (size_t)row * D_MODEL); const float4* xr = (const float4*)(a.x + (size_t)row * D_MODEL);
    bf16_t* H2 = (bf16_t*)(a.ws + WS_H2);
    float4 v[8]; float ss = 0.f;
#pragma unroll
    for (int j = 0; j < 8; ++j) { v[j] = mr[lane + 64 * j]; ss += v[j].x * v[j].x + v[j].y * v[j].y + v[j].z * v[j].z + v[j].w * v[j].w; }
    ss = wave_sum(ss);
    const float r = 1.f / sqrtf(ss * (1.f / D_MODEL) + EPS);
    float s2 = 0.f;
#pragma unroll
    for (int j = 0; j < 8; ++j) {
        const float4 gp = *(const float4*)(a.g_mix_post + (lane + 64 * j) * 4); const float4 xv = xr[lane + 64 * j];
        v[j].x = xv.x + v[j].x * r * gp.x; v[j].y = xv.y + v[j].y * r * gp.y; v[j].z = xv.z + v[j].z * r * gp.z; v[j].w = xv.w + v[j].w * r * gp.w;
        s2 += v[j].x * v[j].x + v[j].y * v[j].y + v[j].z * v[j].z + v[j].w * v[j].w;
        ((float4*)(a.out + (size_t)row * D_MODEL))[lane + 64 * j] = v[j];
    }
    s2 = wave_sum(s2);
    const float r2 = 1.f / sqrtf(s2 * (1.f / D_MODEL) + EPS);
#pragma unroll
    for (int j = 0; j < 8; ++j) {
        const float4 g2 = *(const float4*)(a.g_ffn_pre + (lane + 64 * j) * 4);
        uint2 o; o.x = pk2(v[j].x * r2 * g2.x, v[j].y * r2 * g2.y); o.y = pk2(v[j].z * r2 * g2.z, v[j].w * r2 * g2.w);
        *(uint2*)(H2 + (size_t)row * D_MODEL + (lane + 64 * j) * 4) = o;
    }
}
__device__ __forceinline__ void stageJ_row(const Args& a, int row, int lane) {
    const float4* fr = (const float4*)((const float*)(a.ws + WS_FFN) + (size_t)row * D_MODEL); float4* orow = (float4*)(a.out + (size_t)row * D_MODEL);
    float4 v[8]; float ss = 0.f;
#pragma unroll
    for (int j = 0; j < 8; ++j) { v[j] = fr[lane + 64 * j]; ss += v[j].x * v[j].x + v[j].y * v[j].y + v[j].z * v[j].z + v[j].w * v[j].w; }
    ss = wave_sum(ss);
    const float r = 1.f / sqrtf(ss * (1.f / D_MODEL) + EPS);
#pragma unroll
    for (int j = 0; j < 8; ++j) {
        const float4 gp = *(const float4*)(a.g_ffn_post + (lane + 64 * j) * 4); float4 xv = orow[lane + 64 * j];
        xv.x += v[j].x * r * gp.x; xv.y += v[j].y * r * gp.y; xv.z += v[j].z * r * gp.z; xv.w += v[j].w * r * gp.w;
        orow[lane + 64 * j] = xv;
    }
}
__device__ __forceinline__ float fast_gelu_tanh(float x) {
    const float u2 = 1.5957691216057308f * (x + 0.044715f * x * x * x);
    return x * __builtin_amdgcn_rcpf(1.f + __builtin_amdgcn_exp2f(-1.4426950408889634f * u2));
}
__device__ __forceinline__ void phase_H(const Args& a, const Frame& F) {
    const bf16_t* GRAW = (const bf16_t*)(a.ws + WS_GRAW); bf16_t* UP = (bf16_t*)(a.ws + WS_UP);
    constexpr int CG = D_FF / 8;
    const size_t total = (size_t)M_TOK * CG, stride = (size_t)F.G * 512;
    for (size_t i = (size_t)F.vcu * 512 + F.tid; i < total; i += stride) {
        const int row = (int)(i / CG), cg = (int)(i % CG), c0 = cg * 8, t = row % SEQ;
        float acc[8];
        { const float4 b0 = *(const float4*)(a.ffn_conv_b + c0), b1 = *(const float4*)(a.ffn_conv_b + c0 + 4); acc[0] = b0.x; acc[1] = b0.y; acc[2] = b0.z; acc[3] = b0.w; acc[4] = b1.x; acc[5] = b1.y; acc[6] = b1.z; acc[7] = b1.w; }
#pragma unroll
        for (int j = 0; j < 3; ++j) {
            const int tt = t - 2 + j;
            if (tt >= 0) {
                const v4u g = *(const v4u*)(GRAW + (size_t)(row - 2 + j) * D_FF + c0);
                const float4 w0 = *(const float4*)(a.ffn_conv_w + (size_t)j * D_FF + c0), w1 = *(const float4*)(a.ffn_conv_w + (size_t)j * D_FF + c0 + 4);
                acc[0] += w0.x * __uint_as_float(g.x << 16); acc[1] += w0.y * __uint_as_float(g.x & 0xffff0000u);
                acc[2] += w0.z * __uint_as_float(g.y << 16); acc[3] += w0.w * __uint_as_float(g.y & 0xffff0000u);
                acc[4] += w1.x * __uint_as_float(g.z << 16); acc[5] += w1.y * __uint_as_float(g.z & 0xffff0000u);
                acc[6] += w1.z * __uint_as_float(g.w << 16); acc[7] += w1.w * __uint_as_float(g.w & 0xffff0000u);
            }
        }
        v4u* up = (v4u*)(UP + (size_t)row * D_FF + c0); const v4u u = *up;
        const float uu[8] = {__uint_as_float(u.x << 16), __uint_as_float(u.x & 0xffff0000u), __uint_as_float(u.y << 16), __uint_as_float(u.y & 0xffff0000u),
                             __uint_as_float(u.z << 16), __uint_as_float(u.z & 0xffff0000u), __uint_as_float(u.w << 16), __uint_as_float(u.w & 0xffff0000u)};
        v4u o;
        o.x = pk2(fast_gelu_tanh(acc[0]) * uu[0], fast_gelu_tanh(acc[1]) * uu[1]); o.y = pk2(fast_gelu_tanh(acc[2]) * uu[2], fast_gelu_tanh(acc[3]) * uu[3]);
        o.z = pk2(fast_gelu_tanh(acc[4]) * uu[4], fast_gelu_tanh(acc[5]) * uu[5]); o.w = pk2(fast_gelu_tanh(acc[6]) * uu[6], fast_gelu_tanh(acc[7]) * uu[7]);
        *up = o;
    }
}
namespace rc {
typedef short bf16x8 __attribute__((ext_vector_type(8)));
typedef float f32x4 __attribute__((ext_vector_type(4)));
typedef unsigned v2u __attribute__((ext_vector_type(2)));
constexpr size_t WS_DSH = 2 * MiB;
constexpr size_t WS_DCM = 34 * MiB;
constexpr size_t WS_DECH = 66 * MiB;
constexpr size_t WS_DNM = 67 * MiB;
constexpr size_t WS_DECM = 68 * MiB;
constexpr int LQ = 0;
constexpr int LK = 64 * 272;
constexpr int LVT = 2 * 64 * 272;
constexpr int LAT = LVT + 256 * 144;
constexpr int LKT = LAT + 64 * 144;
constexpr int LRED = LKT + 128 * 144;
constexpr int LSC = LRED + 4096;
static_assert(LSC + 1024 <= RING_BYTES, "recurrence LDS map");

__device__ __forceinline__ unsigned pk2f(float lo, float hi) { return pg8::cvt_pk_bf16(lo, hi); }
__device__ __forceinline__ float bflo(unsigned u) { return __uint_as_float(u << 16); }
__device__ __forceinline__ float bfhi(unsigned u) { return __uint_as_float(u & 0xffff0000u); }
#define RC_BAR() do { asm volatile("s_waitcnt vmcnt(0) lgkmcnt(0)" ::: "memory"); __builtin_amdgcn_s_barrier(); asm volatile("" ::: "memory"); } while (0)
#define RC_MFMA(a, b, c) __builtin_amdgcn_mfma_f32_16x16x32_bf16(a, b, c, 0, 0, 0)

template <int NE>
__device__ __forceinline__ void load_vT(LAS unsigned char* lds, const bf16_t* V, int tid) {
    constexpr int NOCT = NE / 8;
#pragma unroll
    for (int j = 0; j < (64 * NOCT) / 512; ++j) {
        const int idx = tid + 512 * j, t = idx / NOCT, eo = idx % NOCT;
        const v4u w = *(const v4u*)(V + (size_t)t * 1024 + eo * 8);
        LAS unsigned short* dst = (LAS unsigned short*)(lds + LVT + (eo * 8) * 144 + t * 2);
        dst[0 * 72] = (unsigned short)(w.x & 0xffffu); dst[1 * 72] = (unsigned short)(w.x >> 16); dst[2 * 72] = (unsigned short)(w.y & 0xffffu); dst[3 * 72] = (unsigned short)(w.y >> 16);
        dst[4 * 72] = (unsigned short)(w.z & 0xffffu); dst[5 * 72] = (unsigned short)(w.z >> 16); dst[6 * 72] = (unsigned short)(w.w & 0xffffu); dst[7 * 72] = (unsigned short)(w.w >> 16);
    }
}
__device__ __forceinline__ void hg_cumsum(LAS unsigned char* lds, const float* LOGFp  , int tid, float (&lf)[16], float (&bb)[16], float& total) {
    const int d = tid & 127, tq = tid >> 7;
    LAS float* part = (LAS float*)(lds + LRED);
#pragma unroll
    for (int i = 0; i < 16; ++i) lf[i] = LOGFp[(size_t)(16 * tq + i) * 1024 + d];
    float c = 0.f;
#pragma unroll
    for (int i = 0; i < 16; ++i) { c += lf[i]; bb[i] = c; }
    part[tq * 128 + d] = c;
    RC_BAR();
    const float p0 = part[d], p1 = part[128 + d], p2 = part[256 + d], p3 = part[384 + d];
    const float prefix = tq == 0 ? 0.f : tq == 1 ? p0 : tq == 2 ? p0 + p1 : p0 + p1 + p2;
    total = (p0 + p1) + (p2 + p3);
#pragma unroll
    for (int i = 0; i < 16; ++i) bb[i] += prefix;
}

__device__ __forceinline__ void hg_L(const Args& a, LAS unsigned char* lds, int item, int tid) {
    const int bh = item >> 5, n = item & 31, b = bh >> 3, h = bh & 7, row0 = b * SEQ + n * 64, col0 = h * 128;
    const int lane = tid & 63, w = __builtin_amdgcn_readfirstlane(tid >> 6), fr = lane & 15, fq = lane >> 4;
    float lf[16], bb[16], total;
    hg_cumsum(lds, (const float*)(a.ws + WS_LOGF) + (size_t)row0 * 1024 + col0, tid, lf, bb, total);
    {
        const int d = tid & 127, tq = tid >> 7;
        unsigned pk[8];
#pragma unroll
        for (int i = 0; i < 8; ++i) {
            const float k0 = (1.f - __expf(lf[2 * i])) * __expf(total - bb[2 * i]), k1 = (1.f - __expf(lf[2 * i + 1])) * __expf(total - bb[2 * i + 1]);
            pk[i] = pk2f(k0, k1);
        }
        LAS v4u* dst = (LAS v4u*)(lds + LKT + d * 144 + tq * 32);
        dst[0] = (v4u){pk[0], pk[1], pk[2], pk[3]}; dst[1] = (v4u){pk[4], pk[5], pk[6], pk[7]};
        if (tq == 0) ((float*)(a.ws + WS_DECH))[(size_t)(bh * 32 + n) * 128 + d] = __expf(total);
    }
    load_vT<128>(lds, (const bf16_t*)(a.ws + WS_VH) + (size_t)row0 * 1024 + col0, tid);
    RC_BAR();
    {
        bf16x8 fe[2];
#pragma unroll
        for (int ks = 0; ks < 2; ++ks) fe[ks] = *(const LAS bf16x8*)(lds + LVT + (16 * w + fr) * 144 + (8 * fq + 32 * ks) * 2);
        bf16_t* out = (bf16_t*)(a.ws + WS_DSH) + ((size_t)(bh * 32 + n) * 128 + 16 * w + fr) * 128 + 4 * fq;
#pragma unroll
        for (int dt = 0; dt < 8; ++dt) {
            f32x4 acc = (f32x4){0.f, 0.f, 0.f, 0.f};
#pragma unroll
            for (int ks = 0; ks < 2; ++ks) { const bf16x8 fd = *(const LAS bf16x8*)(lds + LKT + (16 * dt + fr) * 144 + (8 * fq + 32 * ks) * 2); acc = RC_MFMA(fd, fe[ks], acc); }
            uint2 o; o.x = pk2f(acc[0], acc[1]); o.y = pk2f(acc[2], acc[3]);
            *(uint2*)(out + 16 * dt) = o;
        }
    }
    RC_BAR();
}
__device__ __forceinline__ void hg_O(const Args& a, LAS unsigned char* lds, int item, int tid) {
    const int bh = item >> 5, n = item & 31, b = bh >> 3, h = bh & 7, row0 = b * SEQ + n * 64, col0 = h * 128;
    const int lane = tid & 63, w = __builtin_amdgcn_readfirstlane(tid >> 6), fr = lane & 15, fq = lane >> 4;
    float lf[16], bb[16], total;
    hg_cumsum(lds, (const float*)(a.ws + WS_LOGF) + (size_t)row0 * 1024 + col0, tid, lf, bb, total);
    {
        const int d = tid & 127, tq = tid >> 7;
        const bf16_t* qp = (const bf16_t*)(a.ws + WS_QH) + (size_t)(row0 + 16 * tq) * 1024 + col0 + d;
        LAS unsigned short* lq = (LAS unsigned short*)(lds + LQ + (16 * tq) * 272 + d * 2);
        LAS unsigned short* lk = (LAS unsigned short*)(lds + LK + (16 * tq) * 272 + d * 2);
#pragma unroll
        for (int i = 0; i < 16; ++i) {
            const float q = bf2f(qp[(size_t)i * 1024]);
            const float eb = __expf(bb[i]);
            const float qd = q * eb, ki = (1.f - __expf(lf[i])) * __builtin_amdgcn_rcpf(eb);
            const unsigned p = pk2f(qd, ki);
            lq[i * 136] = (unsigned short)(p & 0xffffu); lk[i * 136] = (unsigned short)(p >> 16);
        }
    }
    load_vT<128>(lds, (const bf16_t*)(a.ws + WS_VH) + (size_t)row0 * 1024 + col0, tid);
    RC_BAR();
    {
        const int tt = w >> 1;
        bf16x8 fqv[4];
#pragma unroll
        for (int ks = 0; ks < 4; ++ks) fqv[ks] = *(const LAS bf16x8*)(lds + LQ + (16 * tt + fr) * 272 + (8 * fq + 32 * ks) * 2);
#pragma unroll
        for (int j = 0; j < 2; ++j) {
            const int st = 2 * (w & 1) + j;
            f32x4 acc = (f32x4){0.f, 0.f, 0.f, 0.f};
            if (st <= tt) {
#pragma unroll
                for (int ks = 0; ks < 4; ++ks) { const bf16x8 fk = *(const LAS bf16x8*)(lds + LK + (16 * st + fr) * 272 + (8 * fq + 32 * ks) * 2); acc = RC_MFMA(fk, fqv[ks], acc); }
                if (st == tt) {
#pragma unroll
                    for (int r = 0; r < 4; ++r) if (4 * fq + r > fr) acc[r] = 0.f;
                }
            }
            v2u o; o.x = pk2f(acc[0], acc[1]); o.y = pk2f(acc[2], acc[3]);
            *(LAS v2u*)(lds + LAT + (16 * tt + fr) * 144 + (16 * st + 4 * fq) * 2) = o;
        }
    }
    RC_BAR();
    {
        bf16x8 fv[2], fs[4];
        const bf16_t* sp = (const bf16_t*)(a.ws + WS_DSH) + ((size_t)(bh * 32 + n) * 128 + 16 * w + fr) * 128 + 8 * fq;
#pragma unroll
        for (int ks = 0; ks < 4; ++ks) fs[ks] = *(const bf16x8*)(sp + 32 * ks);
#pragma unroll
        for (int ks = 0; ks < 2; ++ks) fv[ks] = *(const LAS bf16x8*)(lds + LVT + (16 * w + fr) * 144 + (8 * fq + 32 * ks) * 2);
        f32x4 acc[4];
#pragma unroll
        for (int tt = 0; tt < 4; ++tt) {
            acc[tt] = (f32x4){0.f, 0.f, 0.f, 0.f};
#pragma unroll
            for (int ks = 0; ks < 2; ++ks) { const bf16x8 fa = *(const LAS bf16x8*)(lds + LAT + (16 * tt + fr) * 144 + (8 * fq + 32 * ks) * 2); acc[tt] = RC_MFMA(fv[ks], fa, acc[tt]); }
#pragma unroll
            for (int ks = 0; ks < 4; ++ks) { const bf16x8 fqd = *(const LAS bf16x8*)(lds + LQ + (16 * tt + fr) * 272 + (8 * fq + 32 * ks) * 2); acc[tt] = RC_MFMA(fs[ks], fqd, acc[tt]); }
        }
        LAS float* red = (LAS float*)(lds + LRED);
#pragma unroll
        for (int tt = 0; tt < 4; ++tt) {
            float s = (acc[tt][0] * acc[tt][0] + acc[tt][1] * acc[tt][1]) + (acc[tt][2] * acc[tt][2] + acc[tt][3] * acc[tt][3]);
            s += __shfl_xor(s, 16); s += __shfl_xor(s, 32);
            if (fq == 0) red[(16 * tt + fr) * 8 + w] = s;
        }
        RC_BAR();
        const f32x4 gn = *(const f32x4*)(a.hg_norm + col0 + 16 * w + 4 * fq);
#pragma unroll
        for (int tt = 0; tt < 4; ++tt) {
            const int t = 16 * tt + fr;
            const f32x4 r0 = *(const LAS f32x4*)(red + t * 8), r1 = *(const LAS f32x4*)(red + t * 8 + 4);
            const float ss = ((r0[0] + r0[1]) + (r0[2] + r0[3])) + ((r1[0] + r1[1]) + (r1[2] + r1[3]));
            const float rn = 1.f / sqrtf(ss * (1.f / 128.f) + EPS);
            const size_t off = (size_t)(row0 + t) * 1024 + col0 + 16 * w + 4 * fq;
            const uint2 g = *(const uint2*)((const bf16_t*)(a.ws + WS_GH) + off);
            uint2 o;
            o.x = pk2f(acc[tt][0] * rn * gn[0] * bflo(g.x), acc[tt][1] * rn * gn[1] * bfhi(g.x));
            o.y = pk2f(acc[tt][2] * rn * gn[2] * bflo(g.y), acc[tt][3] * rn * gn[3] * bfhi(g.y));
            *(uint2*)((bf16_t*)(a.ws + WS_YA) + off) = o;
        }
    }
    RC_BAR();
}

__device__ __forceinline__ float log_sigmoid_f(float x) { return fminf(x, 0.f) - log1pf(expf(-fabsf(x))); }
__device__ __forceinline__ float ml_scalars(const Args& a, LAS unsigned char* lds, int row0, int h, int lane) {
    const float* G = (const float*)(a.ws + WS_GATES) + (size_t)(row0 + lane) * 8;
    const float ig = G[h], fg = G[4 + h];
    float bsum = log_sigmoid_f(fg);
#pragma unroll
    for (int o = 1; o < 64; o <<= 1) { const float up = __shfl_up(bsum, o); if (lane >= o) bsum += up; }
    const float bl = __shfl(bsum, 63);
    const float kscale = 0.08838834764831845f;
    LAS float* sc = (LAS float*)(lds + LSC);
    sc[lane] = expf(bsum); sc[64 + lane] = kscale * expf(ig - bsum); sc[128 + lane] = kscale * expf(bl - bsum + ig);
    return expf(bl);
}
template <int NT>
__device__ __forceinline__ void ml_conv8(const Args& a, const bf16_t* MQK, int rowbase  , int tseq0  , int tl0  , int c0, float (&out)[NT][8]) {
    float x[NT + 3][8];
#pragma unroll
    for (int r = 0; r < NT + 3; ++r) {
        const int tl = tl0 - 3 + r;
        if (tseq0 + tl >= 0) { const v4u w = *(const v4u*)(MQK + (size_t)(rowbase + tl) * 1024 + c0);
            x[r][0] = bflo(w.x); x[r][1] = bfhi(w.x); x[r][2] = bflo(w.y); x[r][3] = bfhi(w.y); x[r][4] = bflo(w.z); x[r][5] = bfhi(w.z); x[r][6] = bflo(w.w); x[r][7] = bfhi(w.w); }
        else {
#pragma unroll
            for (int c = 0; c < 8; ++c) x[r][c] = 0.f; }
    }
    float wj[4][8], bj[8];
#pragma unroll
    for (int j = 0; j < 4; ++j) { const f32x4 w0 = *(const f32x4*)(a.ml_conv_w + j * 1024 + c0), w1 = *(const f32x4*)(a.ml_conv_w + j * 1024 + c0 + 4);
        wj[j][0] = w0[0]; wj[j][1] = w0[1]; wj[j][2] = w0[2]; wj[j][3] = w0[3]; wj[j][4] = w1[0]; wj[j][5] = w1[1]; wj[j][6] = w1[2]; wj[j][7] = w1[3]; }
    { const f32x4 b0 = *(const f32x4*)(a.ml_conv_b + c0), b1 = *(const f32x4*)(a.ml_conv_b + c0 + 4); bj[0] = b0[0]; bj[1] = b0[1]; bj[2] = b0[2]; bj[3] = b0[3]; bj[4] = b1[0]; bj[5] = b1[1]; bj[6] = b1[2]; bj[7] = b1[3]; }
#pragma unroll
    for (int i = 0; i < NT; ++i)
#pragma unroll
        for (int c = 0; c < 8; ++c) { const float s = bj[c] + ((wj[0][c] * x[i][c] + wj[1][c] * x[i + 1][c]) + (wj[2][c] * x[i + 2][c] + wj[3][c] * x[i + 3][c])); out[i][c] = s * pg8::fast_sigmoid(s); }
}
__device__ __forceinline__ void ml_L(const Args& a, LAS unsigned char* lds, int item, int tid) {
    const int bh = item >> 5, n = item & 31, b = bh >> 2, h = bh & 3, row0 = b * SEQ + n * 64;
    const int lane = tid & 63, w = __builtin_amdgcn_readfirstlane(tid >> 6), fr = lane & 15, fq = lane >> 4;
    if (w == 0) { const float dec = ml_scalars(a, lds, row0, h, lane); if (lane == 0) ((float*)(a.ws + WS_DECM))[bh * 32 + n] = dec; }
    load_vT<256>(lds, (const bf16_t*)(a.ws + WS_MV) + (size_t)row0 * 1024 + h * 256, tid);
    RC_BAR();
    {
        const int oct = tid & 15, tg = tid >> 4;
        float kv[2][8];
        ml_conv8<2>(a, (const bf16_t*)(a.ws + WS_MQK), row0, n * 64, 2 * tg, 512 + h * 128 + oct * 8, kv);
        const LAS float* sc = (const LAS float*)(lds + LSC + 512);
        const float c0 = sc[2 * tg], c1 = sc[2 * tg + 1];
#pragma unroll
        for (int c = 0; c < 8; ++c) *(LAS unsigned*)(lds + LKT + (oct * 8 + c) * 144 + (2 * tg) * 2) = pk2f(kv[0][c] * c0, kv[1][c] * c1);
    }
    RC_BAR();
    if (tid < 128) {
        float s = 0.f;
#pragma unroll
        for (int j = 0; j < 8; ++j) { const v4u q = *(const LAS v4u*)(lds + LKT + tid * 144 + j * 16); s += ((bflo(q.x) + bfhi(q.x)) + (bflo(q.y) + bfhi(q.y))) + ((bflo(q.z) + bfhi(q.z)) + (bflo(q.w) + bfhi(q.w))); }
        ((float*)(a.ws + WS_DNM))[(size_t)(bh * 32 + n) * 128 + tid] = s;
    }
    {
#pragma unroll
        for (int et = 0; et < 2; ++et) {
            bf16x8 fe[2];
#pragma unroll
            for (int ks = 0; ks < 2; ++ks) fe[ks] = *(const LAS bf16x8*)(lds + LVT + (32 * w + 16 * et + fr) * 144 + (8 * fq + 32 * ks) * 2);
            bf16_t* out = (bf16_t*)(a.ws + WS_DCM) + ((size_t)(bh * 32 + n) * 256 + 32 * w + 16 * et + fr) * 128 + 4 * fq;
#pragma unroll
            for (int dt = 0; dt < 8; ++dt) {
                f32x4 acc = (f32x4){0.f, 0.f, 0.f, 0.f};
#pragma unroll
                for (int ks = 0; ks < 2; ++ks) { const bf16x8 fd = *(const LAS bf16x8*)(lds + LKT + (16 * dt + fr) * 144 + (8 * fq + 32 * ks) * 2); acc = RC_MFMA(fd, fe[ks], acc); }
                uint2 o; o.x = pk2f(acc[0], acc[1]); o.y = pk2f(acc[2], acc[3]);
                *(uint2*)(out + 16 * dt) = o;
            }
        }
    }
    RC_BAR();
}
__device__ __forceinline__ void ml_O(const Args& a, LAS unsigned char* lds, int item, int tid) {
    const int bh = item >> 5, n = item & 31, b = bh >> 2, h = bh & 3, row0 = b * SEQ + n * 64;
    const int lane = tid & 63, w = __builtin_amdgcn_readfirstlane(tid >> 6), fr = lane & 15, fq = lane >> 4;
    if (w == 0) (void)ml_scalars(a, lds, row0, h, lane);
    load_vT<256>(lds, (const bf16_t*)(a.ws + WS_MV) + (size_t)row0 * 1024 + h * 256, tid);
    RC_BAR();
    {
        const int oct = tid & 31, tg = tid >> 5, isk = oct >> 4, o8 = (oct & 15) * 8;
        float qv[4][8];
        ml_conv8<4>(a, (const bf16_t*)(a.ws + WS_MQK), row0, n * 64, 4 * tg, isk * 512 + h * 128 + o8, qv);
        const LAS float* sc = (const LAS float*)(lds + LSC + isk * 256);
#pragma unroll
        for (int i = 0; i < 4; ++i) {
            const float s = sc[4 * tg + i];
            v4u o; o.x = pk2f(qv[i][0] * s, qv[i][1] * s); o.y = pk2f(qv[i][2] * s, qv[i][3] * s); o.z = pk2f(qv[i][4] * s, qv[i][5] * s); o.w = pk2f(qv[i][6] * s, qv[i][7] * s);
            *(LAS v4u*)(lds + (isk ? LK : LQ) + (4 * tg + i) * 272 + o8 * 2) = o;
        }
    }
    RC_BAR();
    LAS float* red = (LAS float*)(lds + LRED);
    {
        const int tt = w >> 1;
        bf16x8 fqv[4];
#pragma unroll
        for (int ks = 0; ks < 4; ++ks) fqv[ks] = *(const LAS bf16x8*)(lds + LQ + (16 * tt + fr) * 272 + (8 * fq + 32 * ks) * 2);
#pragma unroll
        for (int j = 0; j < 2; ++j) {
            const int st = 2 * (w & 1) + j;
            f32x4 acc = (f32x4){0.f, 0.f, 0.f, 0.f};
            if (st <= tt) {
#pragma unroll
                for (int ks = 0; ks < 4; ++ks) { const bf16x8 fk = *(const LAS bf16x8*)(lds + LK + (16 * st + fr) * 272 + (8 * fq + 32 * ks) * 2); acc = RC_MFMA(fk, fqv[ks], acc); }
                if (st == tt) {
#pragma unroll
                    for (int r = 0; r < 4; ++r) if (4 * fq + r > fr) acc[r] = 0.f;
                }
            }
            float s = (acc[0] + acc[1]) + (acc[2] + acc[3]);
            s += __shfl_xor(s, 16); s += __shfl_xor(s, 32);
            if (fq == 0) red[(16 * tt + fr) * 4 + st] = s;
            v2u o; o.x = pk2f(acc[0], acc[1]); o.y = pk2f(acc[2], acc[3]);
            *(LAS v2u*)(lds + LAT + (16 * tt + fr) * 144 + (16 * st + 4 * fq) * 2) = o;
        }
        const int t = tid >> 3, part = tid & 7;
        const float* np = (const float*)(a.ws + WS_DNM) + (size_t)(bh * 32 + n) * 128 + part * 16;
        float dsum = 0.f;
#pragma unroll
        for (int j = 0; j < 2; ++j) {
            const v4u q = *(const LAS v4u*)(lds + LQ + t * 272 + (part * 16 + j * 8) * 2);
            const f32x4 n0 = *(const f32x4*)(np + j * 8), n1 = *(const f32x4*)(np + j * 8 + 4);
            dsum += ((bflo(q.x) * n0[0] + bfhi(q.x) * n0[1]) + (bflo(q.y) * n0[2] + bfhi(q.y) * n0[3])) + ((bflo(q.z) * n1[0] + bfhi(q.z) * n1[1]) + (bflo(q.w) * n1[2] + bfhi(q.w) * n1[3]));
        }
        dsum += __shfl_xor(dsum, 1); dsum += __shfl_xor(dsum, 2); dsum += __shfl_xor(dsum, 4);
        if (part == 0) red[256 + t] = dsum;
    }
    RC_BAR();
    {
        f32x4 acc[2][4];
#pragma unroll
        for (int et = 0; et < 2; ++et) {
            bf16x8 fv[2], fc[4];
            const bf16_t* cp = (const bf16_t*)(a.ws + WS_DCM) + ((size_t)(bh * 32 + n) * 256 + 32 * w + 16 * et + fr) * 128 + 8 * fq;
#pragma unroll
            for (int ks = 0; ks < 4; ++ks) fc[ks] = *(const bf16x8*)(cp + 32 * ks);
#pragma unroll
            for (int ks = 0; ks < 2; ++ks) fv[ks] = *(const LAS bf16x8*)(lds + LVT + (32 * w + 16 * et + fr) * 144 + (8 * fq + 32 * ks) * 2);
#pragma unroll
            for (int tt = 0; tt < 4; ++tt) {
                f32x4 c = (f32x4){0.f, 0.f, 0.f, 0.f};
#pragma unroll
                for (int ks = 0; ks < 2; ++ks) { const bf16x8 fa = *(const LAS bf16x8*)(lds + LAT + (16 * tt + fr) * 144 + (8 * fq + 32 * ks) * 2); c = RC_MFMA(fv[ks], fa, c); }
#pragma unroll
                for (int ks = 0; ks < 4; ++ks) { const bf16x8 fqd = *(const LAS bf16x8*)(lds + LQ + (16 * tt + fr) * 272 + (8 * fq + 32 * ks) * 2); c = RC_MFMA(fc[ks], fqd, c); }
                acc[et][tt] = c;
            }
        }
        float dn[4];
#pragma unroll
        for (int tt = 0; tt < 4; ++tt) {
            const int t = 16 * tt + fr;
            const f32x4 rs = *(const LAS f32x4*)(red + t * 4);
            const float den = ((rs[0] + rs[1]) + (rs[2] + rs[3])) + red[256 + t];
            dn[tt] = 1.f / fmaxf(fabsf(den), 1.f);
            float s = 0.f;
#pragma unroll
            for (int et = 0; et < 2; ++et) { acc[et][tt] = acc[et][tt] * dn[tt]; s += (acc[et][tt][0] * acc[et][tt][0] + acc[et][tt][1] * acc[et][tt][1]) + (acc[et][tt][2] * acc[et][tt][2] + acc[et][tt][3] * acc[et][tt][3]); }
            s += __shfl_xor(s, 16); s += __shfl_xor(s, 32);
            if (fq == 0) red[512 + t * 8 + w] = s;
        }
        RC_BAR();
#pragma unroll
        for (int tt = 0; tt < 4; ++tt) {
            const int t = 16 * tt + fr;
            const f32x4 r0 = *(const LAS f32x4*)(red + 512 + t * 8), r1 = *(const LAS f32x4*)(red + 512 + t * 8 + 4);
            const float ss = ((r0[0] + r0[1]) + (r0[2] + r0[3])) + ((r1[0] + r1[1]) + (r1[2] + r1[3]));
            const float rn = 1.f / sqrtf(ss * (1.f / 256.f) + EPS);
#pragma unroll
            for (int et = 0; et < 2; ++et) {
                const int e = 32 * w + 16 * et + 4 * fq;
                const f32x4 gn = *(const f32x4*)(a.ml_norm + h * 256 + e);
                const size_t off = (size_t)(row0 + t) * 1024 + h * 256 + e;
                const uint2 g = *(const uint2*)((const bf16_t*)(a.ws + WS_MO) + off);
                uint2 o;
                o.x = pk2f(acc[et][tt][0] * rn * gn[0] * bflo(g.x), acc[et][tt][1] * rn * gn[1] * bfhi(g.x));
                o.y = pk2f(acc[et][tt][2] * rn * gn[2] * bflo(g.y), acc[et][tt][3] * rn * gn[3] * bfhi(g.y));
                *(uint2*)((bf16_t*)(a.ws + WS_YB) + off) = o;
            }
        }
    }
    RC_BAR();
}

__device__ __forceinline__ void phase_L(const Args& a, const Frame& F) {
#ifndef RC_SKIP_HG
    for (int it = F.vcu; it < 1024; it += F.G) hg_L(a, F.lds + RING_OFF, it, F.tid);
#endif
#ifndef RC_SKIP_ML
    for (int it = F.vcu; it < 512; it += F.G) ml_L(a, F.lds + RING_OFF, it, F.tid);
#endif
}
__device__ __forceinline__ void phase_S(const Args& a, const Frame& F) {
    const int gt = F.vcu * 512 + F.tid, GT = F.G * 512;
#ifndef RC_SKIP_HG
    {
        unsigned* DS = (unsigned*)(a.ws + WS_DSH); const float* DEC = (const float*)(a.ws + WS_DECH);
        for (int p = gt; p < 32 * 128 * 64; p += GT) {
            const int bh = p >> 13, e = (p >> 6) & 127, dp = p & 63;
            unsigned* ds = DS + ((size_t)(bh * 32) * 128 + e) * 64 + dp; const float* dc = DEC + (size_t)(bh * 32) * 128 + 2 * dp;
            float s0 = 0.f, s1 = 0.f;
#pragma unroll 1
            for (int n0 = 0; n0 < 32; n0 += 8) {
                unsigned u[8]; float2 dv[8];
#pragma unroll
                for (int j = 0; j < 8; ++j) { u[j] = ds[(size_t)(n0 + j) * 128 * 64]; dv[j] = *(const float2*)(dc + (size_t)(n0 + j) * 128); }
#pragma unroll
                for (int j = 0; j < 8; ++j) { ds[(size_t)(n0 + j) * 128 * 64] = pk2f(s0, s1); s0 = dv[j].x * s0 + bflo(u[j]); s1 = dv[j].y * s1 + bfhi(u[j]); }
            }
        }
    }
#endif
#ifndef RC_SKIP_ML
    {
        unsigned* DC = (unsigned*)(a.ws + WS_DCM); const float* DEC = (const float*)(a.ws + WS_DECM);
        for (int p = gt; p < 16 * 256 * 64; p += GT) {
            const int bh = p >> 14, e = (p >> 6) & 255, dp = p & 63;
            unsigned* dc = DC + ((size_t)(bh * 32) * 256 + e) * 64 + dp; const float* de = DEC + bh * 32;
            float s0 = 0.f, s1 = 0.f;
#pragma unroll 1
            for (int n0 = 0; n0 < 32; n0 += 8) {
                unsigned u[8]; float dv[8];
#pragma unroll
                for (int j = 0; j < 8; ++j) { u[j] = dc[(size_t)(n0 + j) * 256 * 64]; dv[j] = de[n0 + j]; }
#pragma unroll
                for (int j = 0; j < 8; ++j) { dc[(size_t)(n0 + j) * 256 * 64] = pk2f(s0, s1); s0 = dv[j] * s0 + bflo(u[j]); s1 = dv[j] * s1 + bfhi(u[j]); }
            }
        }
        float* DN = (float*)(a.ws + WS_DNM);
        for (int p = gt; p < 16 * 128; p += GT) {
            const int bh = p >> 7, d = p & 127; float s = 0.f;
            for (int n = 0; n < 32; ++n) { float* q = DN + (size_t)(bh * 32 + n) * 128 + d; const float u = *q; *q = s; s = DEC[bh * 32 + n] * s + u; }
        }
    }
#endif
}
__device__ __forceinline__ void phase_O(const Args& a, const Frame& F) {
#ifndef RC_SKIP_HG
    for (int it = F.vcu; it < 1024; it += F.G) hg_O(a, F.lds + RING_OFF, it, F.tid);
#endif
#ifndef RC_SKIP_ML
    for (int it = F.vcu; it < 512; it += F.G) ml_O(a, F.lds + RING_OFF, it, F.tid);
#endif
}
}
constexpr int N_PHASES = 12;
__global__ void __launch_bounds__(NWAVES * 64, 2) mk_fwd(Args args) {
    extern __shared__ __attribute__((aligned(16))) unsigned char lds_raw[];
    Frame F;
    F.lds = (LAS unsigned char*)lds_raw;
    F.tid = threadIdx.x; F.lane = F.tid & 63; F.wave = __builtin_amdgcn_readfirstlane(F.tid >> 6);
    F.G = gridDim.x; { const int bx = blockIdx.x; F.vcu = (F.G % 8 == 0) ? (bx % 8) * (F.G / 8) + bx / 8 : bx; }
    volatile LAS unsigned* MISC = (volatile LAS unsigned*)(F.lds + MISC_OFF);
    gu32* ctl = (gu32*)(args.ws + WS_CTL);
    for (int u = F.tid; u < (LDS_BYTES - LDSCTL_OFF) / 4; u += NWAVES * 64) ((LAS unsigned*)(F.lds + LDSCTL_OFF))[u] = 0u;
    __syncthreads();
    const int lo = args.ph_lo, hi = args.ph_hi;
    XcdBarrier bar; bar.bar = (unsigned*)(ctl + CW_BAR) + args.li * XCD_BAR_WORDS; bar.x = 0; bar.st = nullptr;
    if (hi - lo > 1) bar = xcd_barrier_post((unsigned*)(ctl + CW_BAR) + args.li * XCD_BAR_WORDS, MISC + 8);
#define IN(k) (lo <= (k) && (k) < hi)
#define FRESH() do { int t_ = threadIdx.x; asm volatile("" : "+v"(t_)); F.tid = t_; F.lane = t_ & 63; } while (0)
#define SEAM(k) do { if (IN(k) && IN((k) + 1)) xcd_barrier(bar); } while (0)
    unsigned char* ws = args.ws;

    if (IN(0))  { FRESH(); phase_prep(args, F); } SEAM(0);

    if (IN(1)) {
        pg8::Gemm g{(const bf16_t*)(ws + WS_HB), nullptr, (const bf16_t*)(ws + WS_WINT), nullptr, 2048};
        pg8::StaticOrder S; S.init(M_TOK, 11264, F.G, (int)blockIdx.x);
        pg8::EpiInProj E{ws, args.b_in};
        pg8::gemm_phase<pg8::EpiInProj, pg8::StaticOrder, true, true>(F.lds + RING_OFF, g, S, E);
    } SEAM(1);

    if (IN(2))  { FRESH(); rc::phase_L(args, F); } SEAM(2);
    if (IN(3))  { FRESH(); rc::phase_S(args, F); } SEAM(3);
    if (IN(4))  { FRESH(); rc::phase_O(args, F); } SEAM(4);

    if (IN(5)) {
        pg8::Gemm g{(const bf16_t*)(ws + WS_YA), (const bf16_t*)(ws + WS_YB), (const bf16_t*)(ws + WS_WA), (const bf16_t*)(ws + WS_WB), 1024};
        pg8::StaticOrder S; S.init(M_TOK, 2048, F.G, (int)blockIdx.x, 2);
        pg8::EpiMerge E{(const bf16_t*)(ws + WS_GA), (const bf16_t*)(ws + WS_GB), (bf16_t*)(ws + WS_MERGED)};
        pg8::gemm_phase<pg8::EpiMerge, pg8::StaticOrder, true, true>(F.lds + RING_OFF, g, S, E);
    } SEAM(5);

    if (IN(6)) {
        pg8::Gemm g{(const bf16_t*)(ws + WS_MERGED), nullptr, (const bf16_t*)(ws + WS_WOUT), nullptr, 2048};
        pg8::StaticOrder S; S.init(M_TOK, 2048, F.G, (int)blockIdx.x);
        pg8::EpiF32 E{(float*)(ws + WS_MIX), 2048};
        pg8::gemm_phase<pg8::EpiF32, pg8::StaticOrder, true, true>(F.lds + RING_OFF, g, S, E);
    } SEAM(6);

    if (IN(7)) {
        FRESH();
        const int gw = F.vcu * NWAVES + F.wave, NGW = F.G * NWAVES;
        for (int m = gw; m < M_TOK; m += NGW) stageF_row(args, m, F.lane);
        phase_ffn_weights(args, F);
    } SEAM(7);

    if (IN(8)) {
        pg8::Gemm g{(const bf16_t*)(ws + WS_H2), nullptr, (const bf16_t*)(ws + WS_WG), nullptr, 2048};
        pg8::StaticOrder S; S.init(M_TOK, 2 * D_FF, F.G, (int)blockIdx.x);
        pg8::EpiSplitBf16 E{(bf16_t*)(ws + WS_GRAW), (bf16_t*)(ws + WS_UP), D_FF / 256, D_FF};
        pg8::gemm_phase<pg8::EpiSplitBf16, pg8::StaticOrder, true, true>(F.lds + RING_OFF, g, S, E);
    } SEAM(8);

    if (IN(9))  { FRESH(); phase_H(args, F); } SEAM(9);

    if (IN(10)) {
        pg8::Gemm g{(const bf16_t*)(ws + WS_UP), nullptr, (const bf16_t*)(ws + WS_WD), nullptr, D_FF};
        pg8::StaticOrder S; S.init(M_TOK, 2048, F.G, (int)blockIdx.x);
        pg8::EpiF32 E{(float*)(ws + WS_FFN), 2048};
        pg8::gemm_phase<pg8::EpiF32, pg8::StaticOrder, true, true>(F.lds + RING_OFF, g, S, E);
    } SEAM(10);

    if (IN(11)) {
        FRESH();
        const int gw = F.vcu * NWAVES + F.wave, NGW = F.G * NWAVES;
        for (int m = gw; m < M_TOK; m += NGW) stageJ_row(args, m, F.lane);
    }
#undef IN
#undef SEAM
}

static int g_grid = 0;
static bool fast_init() {
    if (g_grid == 0) {
        int dev = 0, cus = 0;
        if (hipGetDevice(&dev) != hipSuccess || hipDeviceGetAttribute(&cus, hipDeviceAttributeMultiprocessorCount, dev) != hipSuccess) { g_grid = -1; return false; }
        if (hipFuncSetAttribute((const void*)mk_fwd, hipFuncAttributeMaxDynamicSharedMemorySize, LDS_BYTES) != hipSuccess) { fprintf(stderr, "hipFuncSetAttribute failed\n"); g_grid = -1; return false; }
        int per_cu = 0;
        if (hipOccupancyMaxActiveBlocksPerMultiprocessor(&per_cu, (const void*)mk_fwd, NWAVES * 64, LDS_BYTES) != hipSuccess || per_cu < 1) fprintf(stderr, "note: occupancy query says %d\n", per_cu);
        (void)hipGetLastError();
        g_grid = cus;
    }
    return g_grid > 0;
}
static void fast_launch(void* const* d_in, void* d_out, void* d_ws, hipStream_t stream, int lo, int hi, int li) {
    if (!fast_init()) return;
    Args a{};
    const float** dst = (const float**)&a;
    for (int i = 0; i < 20; ++i) dst[i] = (const float*)d_in[i];
    a.out = (float*)d_out; a.ws = (unsigned char*)d_ws; a.ph_lo = lo; a.ph_hi = hi; a.li = li; a.pad = 0;
    hipLaunchKernelGGL(mk_fwd, dim3(g_grid), dim3(NWAVES * 64), LDS_BYTES, stream, a);
}
struct Ptrs {
    const float *x, *g_mix_pre, *g_mix_post, *g_ffn_pre, *g_ffn_post, *w_in, *b_in, *lb_logits, *hg_norm, *ml_conv_w, *ml_conv_b, *ml_norm, *w_up_a, *w_up_b, *w_out, *ffn_w_gate, *ffn_w_up,
        *ffn_conv_w, *ffn_conv_b, *ffn_w_down;
    float* out; unsigned char* ws;
};
static Ptrs make_ptrs(void* const* d_in, void* d_out, void* d_ws) {
    Ptrs p;
    p.x = (const float*)d_in[0]; p.g_mix_pre = (const float*)d_in[1]; p.g_mix_post = (const float*)d_in[2]; p.g_ffn_pre = (const float*)d_in[3]; p.g_ffn_post = (const float*)d_in[4];
    p.w_in = (const float*)d_in[5]; p.b_in = (const float*)d_in[6]; p.lb_logits = (const float*)d_in[7]; p.hg_norm = (const float*)d_in[8]; p.ml_conv_w = (const float*)d_in[9];
    p.ml_conv_b = (const float*)d_in[10]; p.ml_norm = (const float*)d_in[11]; p.w_up_a = (const float*)d_in[12]; p.w_up_b = (const float*)d_in[13]; p.w_out = (const float*)d_in[14];
    p.ffn_w_gate = (const float*)d_in[15]; p.ffn_w_up = (const float*)d_in[16]; p.ffn_conv_w = (const float*)d_in[17]; p.ffn_conv_b = (const float*)d_in[18]; p.ffn_w_down = (const float*)d_in[19];
    p.out = (float*)d_out; p.ws = (unsigned char*)d_ws;
    return p;
}
#define WSP(T, off) ((T*)(p.ws + (off)))

static void gold_stageA(const Ptrs& p, hipStream_t s) {
    gold::k_lb<<<4, 256, 0, s>>>(p.lb_logits, WSP(float, WS_LB));
    gold::k_prep_rows<<<M_TOK / 4, 256, 0, s>>>(p.x, p.g_mix_pre, p.w_in, p.b_in, WSP(bf16_t, WS_HB), WSP(float, WS_GATES));
}
static void gold_stageB(const Ptrs& p, hipStream_t s) {
    auto seg = [&](int col, int n, gold::Epi e) { e.bias = p.b_in + col; gold::gemm<bf16_t><<<dim3(n / 128, M_TOK / 128), 256, 0, s>>>(WSP(bf16_t, WS_HB), D_MODEL, p.w_in + col, IN_W, D_MODEL, e); };
    const float qs = 0.08838834764831845f;
    seg(C_HGQ, 1024, gold::mk(1, WSP(void, WS_QH), 1024, nullptr, nullptr, nullptr, nullptr, qs));
    seg(C_HGF, 1024, gold::mk(3, WSP(void, WS_LOGF), 1024, nullptr, WSP(float, WS_LB), nullptr, nullptr, 1.f));
    seg(C_HGI, 1024, gold::mk(0, WSP(void, WS_VH), 1024, nullptr, nullptr, nullptr, nullptr, 1.f));
    seg(C_HGG, 1024, gold::mk(1, WSP(void, WS_GH), 1024, nullptr, nullptr, nullptr, nullptr, 1.f));
    seg(C_MQK, 1024, gold::mk(0, WSP(void, WS_MQK), 1024, nullptr, nullptr, nullptr, nullptr, 1.f));
    seg(C_MV, 1024, gold::mk(0, WSP(void, WS_MV), 1024, nullptr, nullptr, nullptr, nullptr, 1.f));
    seg(C_MO, 1024, gold::mk(2, WSP(void, WS_MO), 1024, nullptr, nullptr, nullptr, nullptr, 1.f));
    seg(C_GA, 2048, gold::mk(2, WSP(void, WS_GA), 2048, nullptr, nullptr, nullptr, nullptr, 1.f));
    seg(C_GB, 2048, gold::mk(2, WSP(void, WS_GB), 2048, nullptr, nullptr, nullptr, nullptr, 1.f));
}
static void gold_stageC(const Ptrs& p, hipStream_t s) {
    gold::k_mlconv<<<M_TOK * 1024 / 256, 256, 0, s>>>(WSP(bf16_t, WS_MQK), p.ml_conv_w, p.ml_conv_b, WSP(float, WS_MQA));
    gold::k_hgscan<<<BATCH * HG_HEADS * 4, 64, 0, s>>>(WSP(bf16_t, WS_QH), WSP(float, WS_LOGF), WSP(bf16_t, WS_VH), WSP(float, WS_OHG));
    gold::k_hgfin<<<M_TOK * 8 / 4, 256, 0, s>>>(WSP(float, WS_OHG), WSP(bf16_t, WS_GH), p.hg_norm, WSP(bf16_t, WS_YA));
    gold::k_mlscan<<<BATCH * ML_HEADS * 9, 64, 0, s>>>(WSP(float, WS_MQA), WSP(bf16_t, WS_MV), WSP(float, WS_GATES), WSP(float, WS_NUM), WSP(float, WS_DEN));
    gold::k_mlfin<<<M_TOK * 4 / 4, 256, 0, s>>>(WSP(float, WS_NUM), WSP(float, WS_DEN), WSP(bf16_t, WS_MO), p.ml_norm, WSP(bf16_t, WS_YB));
}
static void gold_stageD(const Ptrs& p, hipStream_t s) {
    gold::gemm<bf16_t><<<dim3(2048 / 128, M_TOK / 128), 256, 0, s>>>(WSP(bf16_t, WS_YA), 1024, p.w_up_a, 2048, 1024, gold::mk(5, WSP(void, WS_TMP), 2048, nullptr, nullptr, WSP(void, WS_GA), nullptr, 1.f));
    gold::gemm<bf16_t><<<dim3(2048 / 128, M_TOK / 128), 256, 0, s>>>(WSP(bf16_t, WS_YB), 1024, p.w_up_b, 2048, 1024, gold::mk(6, WSP(void, WS_MERGED), 2048, nullptr, nullptr, WSP(void, WS_GB), WSP(void, WS_TMP), 1.f));
}
static void gold_stageE(const Ptrs& p, hipStream_t s) {
    gold::gemm<bf16_t><<<dim3(2048 / 128, M_TOK / 128), 256, 0, s>>>(WSP(bf16_t, WS_MERGED), 2048, p.w_out, 2048, 2048, gold::mk(4, WSP(void, WS_MIX), 2048, nullptr, nullptr, nullptr, nullptr, 1.f));
}
static void gold_stageF(const Ptrs& p, hipStream_t s) {
    gold::k_stageF<<<M_TOK / 4, 256, 0, s>>>(p.x, WSP(float, WS_MIX), p.g_mix_post, p.g_ffn_pre, p.out, WSP(bf16_t, WS_H2));
}
static void gold_stageG(const Ptrs& p, hipStream_t s) {
    gold::gemm<bf16_t><<<dim3(D_FF / 128, M_TOK / 128), 256, 0, s>>>(WSP(bf16_t, WS_H2), 2048, p.ffn_w_gate, D_FF, 2048, gold::mk(0, WSP(void, WS_GRAW), D_FF, nullptr, nullptr, nullptr, nullptr, 1.f));
    gold::gemm<bf16_t><<<dim3(D_FF / 128, M_TOK / 128), 256, 0, s>>>(WSP(bf16_t, WS_H2), 2048, p.ffn_w_up, D_FF, 2048, gold::mk(0, WSP(void, WS_UP), D_FF, nullptr, nullptr, nullptr, nullptr, 1.f));
}
static void gold_stageH(const Ptrs& p, hipStream_t s) {
    gold::k_stageH<<<(unsigned)((size_t)M_TOK * D_FF / 256), 256, 0, s>>>(WSP(bf16_t, WS_GRAW), WSP(bf16_t, WS_UP), p.ffn_conv_w, p.ffn_conv_b);
}
static void gold_stageI(const Ptrs& p, hipStream_t s) {
    gold::gemm<bf16_t><<<dim3(2048 / 128, M_TOK / 128), 256, 0, s>>>(WSP(bf16_t, WS_UP), D_FF, p.ffn_w_down, 2048, D_FF, gold::mk(4, WSP(void, WS_FFN), 2048, nullptr, nullptr, nullptr, nullptr, 1.f));
}
static void gold_stageJ(const Ptrs& p, hipStream_t s) {
    gold::k_stageJ<<<M_TOK / 4, 256, 0, s>>>(WSP(float, WS_FFN), p.g_ffn_post, p.out);
}
#ifndef FAST_MASK
#define FAST_MASK 0x3ff
#endif
#ifndef ONE_LAUNCH
#define ONE_LAUNCH 1
#endif
extern "C" void kernel_launch(void* const* d_in, const int* in_sizes, int n_in, void* d_out, int out_size, void* d_ws, size_t ws_size, hipStream_t stream) {
    if (n_in != 20 || out_size != M_TOK * D_MODEL || ws_size < WS_END) { fprintf(stderr, "kernel_launch: unexpected shapes n_in %d out %d ws %zu\n", n_in, out_size, ws_size); return; }
    (void)hipMemsetAsync((char*)d_ws + WS_CTL, 0, 1 * MiB, stream);
#if ONE_LAUNCH
    fast_launch(d_in, d_out, d_ws, stream, 0, N_PHASES, 0);
#else
    const Ptrs p = make_ptrs(d_in, d_out, d_ws);
    const unsigned fm = FAST_MASK;
    static const int ph_lo[10] = {0, 1, 2, 5, 6, 7, 8, 9, 10, 11}, ph_hi[10] = {1, 2, 5, 6, 7, 8, 9, 10, 11, 12};
    typedef void (*gold_fn)(const Ptrs&, hipStream_t);
    static const gold_fn gf[10] = {gold_stageA, gold_stageB, gold_stageC, gold_stageD, gold_stageE, gold_stageF, gold_stageG, gold_stageH, gold_stageI, gold_stageJ};
    int li = 0;
    for (int s = 0; s < 10; ++s) {
        if (s == 0 && !(fm & 1) && (fm & 0x1a)) fast_launch(d_in, d_out, d_ws, stream, 0, 1, li++);
        if (s == 5 && !(fm & 0x20) && (fm & 0x140)) fast_launch(d_in, d_out, d_ws, stream, 7, 8, li++);
        if (fm & (1u << s)) fast_launch(d_in, d_out, d_ws, stream, ph_lo[s], ph_hi[s], li++);
        else gf[s](p, stream);
    }
#endif
}
```

```cpp
#include <hip/hip_runtime.h>
#include <cstdint>
#include <cstdio>

constexpr int D_MODEL = 2048, BATCH = 4, SEQ = 2048, M_TOK = BATCH * SEQ;
constexpr int HG_HEADS = 8, HG_DIM = 128, HG_W = 1024;
constexpr int ML_HEADS = 4, ML_QK = 128, ML_V = 256, ML_QKW = 512, ML_VW = 1024;
constexpr int CHUNK = 64, NCHUNK = SEQ / CHUNK;
constexpr int D_FF = 5632, IN_W = 11272;
constexpr float EPS = 1e-6f;
constexpr int C_HGQ = 0, C_HGF = 1024, C_HGI = 2048, C_HGG = 3072, C_MQK = 4096, C_MV = 5120, C_MO = 6144, C_IG = 7168, C_FG = 7172, C_GA = 7176, C_GB = 9224;

constexpr size_t MiB = 1u << 20;
constexpr size_t WS_CTL = 0;
constexpr size_t WS_LB = 1 * MiB;
constexpr size_t WS_GATES = 1 * MiB + 65536;
constexpr size_t WS_DEN = 1 * MiB + 65536 + 262144;
constexpr size_t WS_WINT = 2 * MiB;
constexpr size_t WS_HB = 46 * MiB;
constexpr size_t WS_WA = 78 * MiB, WS_WB = 82 * MiB, WS_WOUT = 86 * MiB;
constexpr size_t WS_QH = 94 * MiB;
constexpr size_t WS_LOGF = 110 * MiB;
constexpr size_t WS_VH = 142 * MiB;
constexpr size_t WS_GH = 158 * MiB;
constexpr size_t WS_MQK = 174 * MiB;
constexpr size_t WS_MV = 190 * MiB;
constexpr size_t WS_MO = 206 * MiB;
constexpr size_t WS_GA = 222 * MiB, WS_GB = 254 * MiB;
constexpr size_t WS_YA = 286 * MiB, WS_YB = 302 * MiB;
constexpr size_t WS_FREE = 318 * MiB;
constexpr size_t WS_MQA = 2 * MiB;
constexpr size_t WS_OHG = 34 * MiB;
constexpr size_t WS_NUM = 318 * MiB;
constexpr size_t WS_TMP = 94 * MiB;
constexpr size_t WS_MERGED = 158 * MiB;
constexpr size_t WS_MIX = 2 * MiB;
constexpr size_t WS_H2 = 66 * MiB;
constexpr size_t WS_WG = 98 * MiB, WS_WU = 120 * MiB, WS_WD = 142 * MiB;
constexpr size_t WS_GRAW = 164 * MiB;
constexpr size_t WS_GTAIL = 164 * MiB, WS_GHEAD = 166 * MiB, WS_UHEAD = 168 * MiB;
constexpr size_t WS_UP = 252 * MiB;
constexpr size_t WS_FFN = 2 * MiB;
constexpr size_t WS_END = 340 * MiB;

typedef unsigned short bf16_t;
__device__ __forceinline__ float bf2f(bf16_t h) { return __uint_as_float(((unsigned)h) << 16); }
__device__ __forceinline__ bf16_t f2bf(float f) { unsigned u = __float_as_uint(f); u += 0x7fffu + ((u >> 16) & 1u); return (bf16_t)(u >> 16); }
__device__ __forceinline__ float sigmoid_f(float x) { return 1.f / (1.f + expf(-x)); }
__device__ __forceinline__ float silu_f(float x) { return x / (1.f + expf(-x)); }
__device__ __forceinline__ float gelu_tanh_f(float x) { const float u = 0.7978845608028654f * (x + 0.044715f * x * x * x); return 0.5f * x * (1.f + tanhf(u)); }
__device__ __forceinline__ float wave_sum(float v) {
#pragma unroll
    for (int o = 1; o < 64; o <<= 1) v += __shfl_xor(v, o);
    return v;
}
namespace pg8 {
#define PG8_LAS __attribute__((address_space(3)))
typedef short bf16x8 __attribute__((ext_vector_type(8)));
typedef float f32x4 __attribute__((ext_vector_type(4)));
typedef float f32x2 __attribute__((ext_vector_type(2)));
typedef unsigned u32x4 __attribute__((ext_vector_type(4)));
typedef unsigned u32x2 __attribute__((ext_vector_type(2)));
constexpr int BM = 256, BK = 64, HALF = 128, HTB = HALF * BK * 2  , STAGE_BYTES = 8 * HTB, NXCD = 8, WGM = 8;

__host__ __device__ __forceinline__ int lds_byte(int r, int c) { const int st = (r >> 4) * 2 + (c >> 5), rr = r & 15, cc = c & 31, ob = rr * 64 + cc * 2; return st * 1024 + (ob ^ (((ob >> 9) & 1) << 5)); }
__host__ __device__ __forceinline__ void stage_rc(int b, int& R, int& C) { const int st = b / 1024, sb = b % 1024, swz = sb ^ (((sb >> 9) & 1) << 5); R = (st >> 1) * 16 + swz / 64; C = (st & 1) * 32 + (swz % 64) / 2; }
__host__ __device__ __forceinline__ int perm32(int rho) { const int n = rho >> 4, i = rho & 15; return 8 * (i >> 2) + 4 * n + (i & 3); }

struct Unit { int pm, pn, sel; };
struct Gemm { const bf16_t* A0; const bf16_t* A1; const bf16_t* B0; const bf16_t* B1; int K; };

struct StaticOrder {
    int nM, nN, nwg, G, c, nsel;
    __host__ __device__ void init(int M, int N, int G_, int c_, int nsel_ = 1) { nM = M / BM; nN = N / BM; nwg = nM * nN; G = G_; c = c_; nsel = nsel_; }
    __host__ __device__ bool next(int i, Unit& u) const {
        const int ti = (nsel == 2) ? (i >> 1) : i;
        const long L = (long)ti * G + c; if (L >= nwg) return false;
        int wgid = (int)L; { const int q = nwg / NXCD, r = nwg % NXCD, xcd = wgid % NXCD, off = wgid / NXCD; wgid = (xcd < r ? xcd * (q + 1) : r * (q + 1) + (xcd - r) * q) + off; }
        const int nig = WGM * nN, gid = wgid / nig, fm = gid * WGM, gsz = (nM - fm) < WGM ? (nM - fm) : WGM;
        u.pm = fm + ((wgid % nig) % gsz); u.pn = (wgid % nig) / gsz; u.sel = (nsel == 2) ? (i & 1) : 0; return true;
    }
};

typedef __bf16 bf16x2_t __attribute__((ext_vector_type(2)));
__device__ __forceinline__ unsigned cvt_pk_bf16(float lo, float hi) { const f32x2 v = {lo, hi}; const bf16x2_t b = __builtin_convertvector(v, bf16x2_t); return __builtin_bit_cast(unsigned, b); }
__device__ __forceinline__ float fast_sigmoid(float x) { return __builtin_amdgcn_rcpf(1.f + __builtin_amdgcn_exp2f(-1.4426950408889634f * x)); }
__device__ __forceinline__ float fast_silu(float x) { return x * fast_sigmoid(x); }
__device__ __forceinline__ u32x4 pack8(const f32x4 a, const f32x4 b) { u32x4 w; w.x = cvt_pk_bf16(a[0], a[1]); w.y = cvt_pk_bf16(a[2], a[3]); w.z = cvt_pk_bf16(b[0], b[1]); w.w = cvt_pk_bf16(b[2], b[3]); return w; }
__device__ __forceinline__ void unpack8(const u32x4 w, f32x4& a, f32x4& b) {
    a[0] = __uint_as_float(w.x << 16); a[1] = __uint_as_float(w.x & 0xffff0000u); a[2] = __uint_as_float(w.y << 16); a[3] = __uint_as_float(w.y & 0xffff0000u);
    b[0] = __uint_as_float(w.z << 16); b[1] = __uint_as_float(w.z & 0xffff0000u); b[2] = __uint_as_float(w.w << 16); b[3] = __uint_as_float(w.w & 0xffff0000u);
}

struct EpiF32 {
    static constexpr bool PERM = false, CHAIN = false;
    float* C; int ldc;
    __device__ __forceinline__ bool operator()(f32x4 (&acc)[2][2][4][2], const Unit& u, int wr, int wc, int fr, int fq) const {
        const int row0 = u.pm * BM + wr * 64 + fr, col0 = u.pn * BM + wc * 32 + 4 * fq;
#pragma unroll
        for (int ai = 0; ai < 2; ++ai)
#pragma unroll
            for (int m = 0; m < 4; ++m) { float* rowp = C + (size_t)(row0 + ai * HALF + m * 16) * ldc + col0;
#pragma unroll
                for (int bj = 0; bj < 2; ++bj)
#pragma unroll
                    for (int n = 0; n < 2; ++n) *(f32x4*)(rowp + bj * HALF + n * 16) = acc[ai][bj][m][n]; }
        return false;
    }
};
struct EpiSplitBf16 {
    static constexpr bool PERM = true, CHAIN = false;
    bf16_t* O0; bf16_t* O1; int ntile0; int ldc;
    __device__ __forceinline__ bool operator()(f32x4 (&acc)[2][2][4][2], const Unit& u, int wr, int wc, int fr, int fq) const {
        const int row0 = u.pm * BM + wr * 64 + fr; const bool second = u.pn >= ntile0; bf16_t* base = second ? O1 : O0;
        const int col0 = (second ? u.pn - ntile0 : u.pn) * BM + wc * 32 + 8 * fq;
#pragma unroll
        for (int ai = 0; ai < 2; ++ai)
#pragma unroll
            for (int m = 0; m < 4; ++m) { bf16_t* rowp = base + (size_t)(row0 + ai * HALF + m * 16) * ldc + col0;
#pragma unroll
                for (int bj = 0; bj < 2; ++bj) *(u32x4*)(rowp + bj * HALF) = pack8(acc[ai][bj][m][0], acc[ai][bj][m][1]); }
        return false;
    }
};
struct EpiInProj {
    static constexpr bool PERM = true, CHAIN = false;
    unsigned char* ws; const float* b_in;
    __device__ __forceinline__ bool operator()(f32x4 (&acc)[2][2][4][2], const Unit& u, int wr, int wc, int fr, int fq) const {
        float* LOGF = (float*)(ws + WS_LOGF); const float* LB = (const float*)(ws + WS_LB);
        const int pn = u.pn; const int seg = pn < 28 ? (pn >> 2) : (pn < 36 ? 7 : 8);
        const int ctile = pn < 28 ? (pn & 3) : (pn < 36 ? pn - 28 : pn - 36);
        const int ld = seg < 7 ? 1024 : 2048;
        const int cseg0 = ctile * BM + wc * 32 + 8 * fq;
        const int borig0 = pn * BM + wc * 32 + 8 * fq + (pn >= 28 ? 8 : 0);
        const int row0 = u.pm * BM + wr * 64 + fr;
        const size_t oboff = seg == 0 ? WS_QH : seg == 2 ? WS_VH : seg == 3 ? WS_GH : seg == 4 ? WS_MQK : seg == 5 ? WS_MV : seg == 6 ? WS_MO : seg == 7 ? WS_GA : WS_GB;
        bf16_t* ob = (bf16_t*)(ws + oboff);
#pragma unroll
        for (int bj = 0; bj < 2; ++bj) {
            const f32x4 b0 = *(const f32x4*)(b_in + borig0 + bj * HALF), b1 = *(const f32x4*)(b_in + borig0 + bj * HALF + 4);
            f32x4 l0 = (f32x4){0.f, 0.f, 0.f, 0.f}, l1 = l0;
            if (seg == 1) { l0 = *(const f32x4*)(LB + cseg0 + bj * HALF); l1 = *(const f32x4*)(LB + cseg0 + bj * HALF + 4); }
#pragma unroll
            for (int ai = 0; ai < 2; ++ai)
#pragma unroll
                for (int m = 0; m < 4; ++m) {
                    f32x4 v0 = acc[ai][bj][m][0] + b0, v1 = acc[ai][bj][m][1] + b1;
                    const size_t off = (size_t)(row0 + ai * HALF + m * 16) * ld + cseg0 + bj * HALF;
                    if (seg == 1) {
#pragma unroll
                        for (int j = 0; j < 4; ++j) { v0[j] = __logf(l0[j] + (1.f - l0[j]) * fast_sigmoid(v0[j])); v1[j] = __logf(l1[j] + (1.f - l1[j]) * fast_sigmoid(v1[j])); }
                        *(f32x4*)(LOGF + off) = v0; *(f32x4*)(LOGF + off + 4) = v1;
                    } else {
                        if (seg == 0) {
#pragma unroll
                            for (int j = 0; j < 4; ++j) { v0[j] = fast_silu(v0[j]) * 0.08838834764831845f; v1[j] = fast_silu(v1[j]) * 0.08838834764831845f; }
                        } else if (seg == 3) {
#pragma unroll
                            for (int j = 0; j < 4; ++j) { v0[j] = fast_silu(v0[j]); v1[j] = fast_silu(v1[j]); }
                        } else if (seg >= 6) {
#pragma unroll
                            for (int j = 0; j < 4; ++j) { v0[j] = fast_sigmoid(v0[j]); v1[j] = fast_sigmoid(v1[j]); }
                        }
                        *(u32x4*)(ob + off) = pack8(v0, v1);
                    }
                }
        }
        return false;
    }
};
__device__ __forceinline__ float dpp_f(float src, const int ctrl_sel) {
    const int s = __float_as_int(src); int r;
    if (ctrl_sel == 0) r = __builtin_amdgcn_update_dpp(0, s, 0x111, 0xf, 0xf, false);
    else if (ctrl_sel == 1) r = __builtin_amdgcn_update_dpp(0, s, 0x112, 0xf, 0xf, false);
    else if (ctrl_sel == 2) r = __builtin_amdgcn_update_dpp(0, s, 0x121, 0xf, 0xf, false);
    else r = __builtin_amdgcn_update_dpp(0, s, 0x122, 0xf, 0xf, false);
    return __int_as_float(r);
}
__device__ __forceinline__ float gelu_tanh_fast(float x) {
    const float u2 = 1.5957691216057308f * (x + 0.044715f * x * x * x);
    return x * __builtin_amdgcn_rcpf(1.f + __builtin_amdgcn_exp2f(-1.4426950408889634f * u2));
}
struct EpiGeglu {
    static constexpr bool PERM = true, CHAIN = false;
    bf16_t* ACT; float* GTAIL; float* GHEAD; float* UHEAD; const float* cw; const float* cb; PG8_LAS float* xch;
    __device__ __forceinline__ bool operator()(f32x4 (&acc)[2][2][4][2], const Unit& u, int wr, int wc, int fr, int fq) const {
        const int f0 = u.pn * 128 + wc * 32 + 8 * fq, wid = wr * 4 + wc;
        if (fr >= 14) {
#pragma unroll
            for (int ai = 0; ai < 2; ++ai)
#pragma unroll
                for (int n = 0; n < 2; ++n)
#pragma unroll
                    for (int j = 0; j < 4; ++j) xch[(((wid * 2 + ai) * 2 + n) * 4 + j) * 8 + fq * 2 + (fr - 14)] = acc[ai][0][3][n][j];
            if (wr == 1) {
                float* gt = GTAIL + ((size_t)u.pm * 2 + (fr - 14)) * D_FF + f0;
                *(f32x4*)gt = acc[1][0][3][0]; *(f32x4*)(gt + 4) = acc[1][0][3][1];
            }
        }
        const bool defer_top = (u.pm & 7) != 0;
        if (defer_top && wr == 0 && fr < 2) {
            float* gh = GHEAD + ((size_t)u.pm * 2 + fr) * D_FF + f0; float* uh = UHEAD + ((size_t)u.pm * 2 + fr) * D_FF + f0;
            *(f32x4*)gh = acc[0][0][0][0]; *(f32x4*)(gh + 4) = acc[0][0][0][1]; *(f32x4*)uh = acc[0][1][0][0]; *(f32x4*)(uh + 4) = acc[0][1][0][1];
        }
        asm volatile("s_waitcnt lgkmcnt(0)" ::: "memory"); __builtin_amdgcn_s_barrier(); asm volatile("" ::: "memory");
        f32x4 w0[2], w1[2], w2[2], bv[2];
#pragma unroll
        for (int n = 0; n < 2; ++n) { w0[n] = *(const f32x4*)(cw + f0 + 4 * n); w1[n] = *(const f32x4*)(cw + D_FF + f0 + 4 * n); w2[n] = *(const f32x4*)(cw + 2 * D_FF + f0 + 4 * n); bv[n] = *(const f32x4*)(cb + f0 + 4 * n); }
        const int row0 = u.pm * BM + wr * 64 + fr;
#pragma unroll
        for (int ai = 0; ai < 2; ++ai) {
            const bool has_src = (wr == 1) || (ai == 1);
            const int sw = (wr == 1) ? wc : 4 + wc, sai = (wr == 1) ? ai : 0;
            f32x4 hv[2];
#pragma unroll
            for (int n = 0; n < 2; ++n)
#pragma unroll
                for (int j = 0; j < 4; ++j) hv[n][j] = has_src ? xch[(((sw * 2 + sai) * 2 + n) * 4 + j) * 8 + fq * 2 + (fr & 1)] : 0.f;
#pragma unroll
            for (int m = 0; m < 4; ++m) {
                f32x4 o[2];
#pragma unroll
                for (int n = 0; n < 2; ++n)
#pragma unroll
                    for (int j = 0; j < 4; ++j) {
                        const float g = acc[ai][0][m][n][j], pv = (m == 0) ? hv[n][j] : acc[ai][0][m - 1][n][j];
                        const float s1 = dpp_f(g, 0), s2 = dpp_f(g, 1), r1 = dpp_f(pv, 2), r2 = dpp_f(pv, 3);
                        const float p1 = fr >= 1 ? s1 : r1, p2 = fr >= 2 ? s2 : r2;
                        const float a = bv[n][j] + ((w0[n][j] * p2 + w1[n][j] * p1) + w2[n][j] * g);
                        o[n][j] = gelu_tanh_fast(a) * acc[ai][1][m][n][j];
                    }
                if (!(defer_top && ai == 0 && wr == 0 && m == 0 && fr < 2))
                    *(u32x4*)(ACT + (size_t)(row0 + ai * HALF + m * 16) * D_FF + f0) = pack8(o[0], o[1]);
            }
        }
        return false;
    }
};
struct EpiMerge {
    static constexpr bool PERM = true, CHAIN = true;
    const bf16_t* GA; const bf16_t* GB; bf16_t* OUT;
    __device__ __forceinline__ bool operator()(f32x4 (&acc)[2][2][4][2], const Unit& u, int wr, int wc, int fr, int fq) const {
        const int row0 = u.pm * BM + wr * 64 + fr, col0 = u.pn * BM + wc * 32 + 8 * fq;
#pragma unroll
        for (int ai = 0; ai < 2; ++ai)
#pragma unroll
            for (int m = 0; m < 4; ++m)
#pragma unroll
                for (int bj = 0; bj < 2; ++bj) {
                    const size_t off = (size_t)(row0 + ai * HALF + m * 16) * 2048 + col0 + bj * HALF;
                    f32x4 gb0, gb1; unpack8(*(const u32x4*)(GB + off), gb0, gb1);
                    if (u.sel == 0) {
                        f32x4 ga0, ga1; unpack8(*(const u32x4*)(GA + off), ga0, ga1);
#pragma unroll
                        for (int j = 0; j < 4; ++j) { acc[ai][bj][m][0][j] *= ga0[j] * __builtin_amdgcn_rcpf(fmaxf(gb0[j], 1e-30f)); acc[ai][bj][m][1][j] *= ga1[j] * __builtin_amdgcn_rcpf(fmaxf(gb1[j], 1e-30f)); }
                    } else {
                        *(u32x4*)(OUT + off) = pack8(acc[ai][bj][m][0] * gb0, acc[ai][bj][m][1] * gb1);
                    }
                }
        return u.sel == 0;
    }
};

template <class Epi, class Sched, bool ALIGN_EPI = false, bool SP2 = false>
__device__ __forceinline__ void gemm_phase(PG8_LAS unsigned char* lds, const Gemm g, const Sched& S, const Epi& E) {
    int tid_ = threadIdx.x; asm volatile("" : "+v"(tid_));
    const int tid = tid_, wid = __builtin_amdgcn_readfirstlane(tid >> 6), lane = tid & 63, wr = wid >> 2, wc = wid & 3, fr = lane & 15, fq = lane >> 4;
    const int K = g.K, nt = K / BK;
    unsigned voffA[2], voffB[2];
#pragma unroll
    for (int i = 0; i < 2; ++i) { int R, C; stage_rc(tid * 16 + i * 8192, R, C); const int Rb = Epi::PERM ? ((R & ~31) + perm32(R & 31)) : R;
        voffA[i] = (unsigned)(R * K + C) * 2u; voffB[i] = (unsigned)(Rb * K + C) * 2u; }
    const size_t kstep = (size_t)(BK * 2);
    const size_t hstep = (size_t)HALF * K * 2;
    const size_t tstep = 2 * hstep;
    const unsigned ldsw = (unsigned)wid * 1024u;
    const int aoff = lds_byte(wr * 64 + fr, fq * 8), boff = lds_byte(wc * 32 + fr, fq * 8);
#define PG8_SA(b, h) (((b) * 2 + (h)) * HTB)
#define PG8_SB(b, h) ((4 + (b) * 2 + (h)) * HTB)
#define PG8_STAGE(bufoff, gbase, voff) do { _Pragma("unroll") for (int _i = 0; _i < 2; ++_i) \
        __builtin_amdgcn_global_load_lds((const unsigned*)((const char*)(gbase) + (voff)[_i]), (PG8_LAS unsigned*)(lds + (bufoff) + ldsw + _i * 8192), 16, 0, 0); } while (0)
#define PG8_LDA(dst, b, h) do { _Pragma("unroll") for (int m = 0; m < 4; ++m) _Pragma("unroll") for (int k = 0; k < 2; ++k) dst[m][k] = *(const PG8_LAS bf16x8*)(lds + PG8_SA(b, h) + aoff + m * 2048 + k * 1024); } while (0)
#define PG8_LDB(dst, b, h) do { _Pragma("unroll") for (int n = 0; n < 2; ++n) _Pragma("unroll") for (int k = 0; k < 2; ++k) dst[n][k] = *(const PG8_LAS bf16x8*)(lds + PG8_SB(b, h) + boff + n * 2048 + k * 1024); } while (0)
#define PG8_MMA(ai, bj, At, Bt) do { __builtin_amdgcn_s_setprio(1); _Pragma("unroll") for (int m = 0; m < 4; ++m) _Pragma("unroll") for (int n = 0; n < 2; ++n) _Pragma("unroll") for (int k = 0; k < 2; ++k) \
        acc[ai][bj][m][n] = __builtin_amdgcn_mfma_f32_16x16x32_bf16(Bt[n][k], At[m][k], acc[ai][bj][m][n], 0, 0, 0); __builtin_amdgcn_s_setprio(0); } while (0)
#define PG8_WAIT_V(n) asm volatile("s_waitcnt vmcnt(" #n ")" ::: "memory")
#define PG8_WAIT_L(n) asm volatile("s_waitcnt lgkmcnt(" #n ")" ::: "memory")
#define PG8_BAR __builtin_amdgcn_s_barrier()
#define PG8_SCHED __builtin_amdgcn_sched_barrier(0)
    Unit cur, nxt; int ui = 0;
    if (!S.next(0, cur)) return;
    f32x4 acc[2][2][4][2];
#pragma unroll
    for (int a = 0; a < 2; ++a)
#pragma unroll
        for (int b = 0; b < 2; ++b)
#pragma unroll
            for (int m = 0; m < 4; ++m)
#pragma unroll
                for (int n = 0; n < 2; ++n) acc[a][b][m][n] = (f32x4){0.f, 0.f, 0.f, 0.f};
    bf16x8 At[4][2], B0[2][2], B1[2][2];
    const char* cA = (const char*)(cur.sel ? g.A1 : g.A0) + (size_t)cur.pm * tstep; const char* cB = (const char*)(cur.sel ? g.B1 : g.B0) + (size_t)cur.pn * tstep;
    if constexpr (SP2) {
        PG8_STAGE(PG8_SB(0, 0), cB, voffB); PG8_STAGE(PG8_SB(0, 1), cB + hstep, voffB); PG8_STAGE(PG8_SA(0, 0), cA, voffA); PG8_STAGE(PG8_SA(0, 1), cA + hstep, voffA);
        if (wr == 1) PG8_BAR;
        PG8_WAIT_V(2); PG8_BAR;
        PG8_STAGE(PG8_SB(1, 0), cB + kstep, voffB); PG8_STAGE(PG8_SA(1, 0), cA + kstep, voffA); PG8_STAGE(PG8_SB(1, 1), cB + hstep + kstep, voffB);
        PG8_WAIT_V(6); PG8_BAR;
    } else {
        PG8_STAGE(PG8_SB(0, 0), cB, voffB); PG8_STAGE(PG8_SA(0, 0), cA, voffA); PG8_STAGE(PG8_SB(0, 1), cB + hstep, voffB); PG8_STAGE(PG8_SA(0, 1), cA + hstep, voffA);
        if (wr == 1) PG8_BAR;
        PG8_WAIT_V(4); PG8_BAR;
        PG8_STAGE(PG8_SB(1, 0), cB + kstep, voffB); PG8_STAGE(PG8_SA(1, 0), cA + kstep, voffA); PG8_STAGE(PG8_SB(1, 1), cB + hstep + kstep, voffB);
        PG8_WAIT_V(6); PG8_BAR;
    }
    for (;;) {
        const bool has_next = S.next(ui + 1, nxt);
        const char* nA = has_next ? (const char*)(nxt.sel ? g.A1 : g.A0) + (size_t)nxt.pm * tstep : cA; const char* nB = has_next ? (const char*)(nxt.sel ? g.B1 : g.B0) + (size_t)nxt.pn * tstep : cB;
        for (int t = 0; t < nt; t += 2) {
            const bool last = (t == nt - 2);
            const char* a1 = cA + (size_t)(t + 1) * kstep;
            const char* a2 = last ? nA : cA + (size_t)(t + 2) * kstep; const char* b2 = last ? nB : cB + (size_t)(t + 2) * kstep;
            const char* a3 = a2 + kstep; const char* b3 = b2 + kstep;
            if constexpr (SP2) {
            PG8_LDB(B0, 0, 0); PG8_LDB(B1, 0, 1); PG8_SCHED; PG8_LDA(At, 0, 0); PG8_STAGE(PG8_SA(1, 1), a1 + hstep, voffA);
            PG8_WAIT_V(8); PG8_WAIT_L(0); PG8_BAR; PG8_MMA(0, 0, At, B0); PG8_MMA(0, 1, At, B1); PG8_BAR; PG8_SCHED;
            PG8_LDA(At, 0, 1); PG8_STAGE(PG8_SB(0, 0), b2, voffB); PG8_STAGE(PG8_SB(0, 1), b2 + hstep, voffB); PG8_STAGE(PG8_SA(0, 0), a2, voffA);
            PG8_WAIT_V(8); PG8_WAIT_L(0); PG8_BAR; PG8_MMA(1, 0, At, B0); PG8_MMA(1, 1, At, B1); PG8_BAR; PG8_SCHED;
            PG8_LDB(B0, 1, 0); PG8_LDB(B1, 1, 1); PG8_SCHED; PG8_LDA(At, 1, 0); PG8_STAGE(PG8_SA(0, 1), a2 + hstep, voffA);
            PG8_WAIT_V(8); PG8_WAIT_L(0); PG8_BAR; PG8_MMA(0, 0, At, B0); PG8_MMA(0, 1, At, B1); PG8_BAR; PG8_SCHED;
            PG8_LDA(At, 1, 1); PG8_STAGE(PG8_SB(1, 0), b3, voffB); PG8_STAGE(PG8_SB(1, 1), b3 + hstep, voffB); PG8_STAGE(PG8_SA(1, 0), a3, voffA);
            PG8_WAIT_V(8); PG8_WAIT_L(0); PG8_BAR; PG8_MMA(1, 0, At, B0); PG8_MMA(1, 1, At, B1); PG8_BAR; PG8_SCHED;
            } else {
            PG8_LDB(B0, 0, 0); PG8_SCHED; PG8_LDA(At, 0, 0); PG8_STAGE(PG8_SA(1, 1), a1 + hstep, voffA);
            PG8_WAIT_L(8); PG8_BAR; PG8_WAIT_L(0); PG8_MMA(0, 0, At, B0); PG8_BAR; PG8_SCHED;
            PG8_LDB(B1, 0, 1); PG8_STAGE(PG8_SB(0, 0), b2, voffB);
            PG8_BAR; PG8_WAIT_L(0); PG8_MMA(0, 1, At, B1); PG8_BAR;
            PG8_LDA(At, 0, 1); PG8_STAGE(PG8_SA(0, 0), a2, voffA);
            PG8_BAR; PG8_WAIT_L(0); PG8_MMA(1, 0, At, B0); PG8_BAR; PG8_SCHED;
            PG8_STAGE(PG8_SB(0, 1), b2 + hstep, voffB);
            PG8_WAIT_V(6); PG8_BAR; PG8_MMA(1, 1, At, B1); PG8_BAR;
            PG8_LDB(B0, 1, 0); PG8_SCHED; PG8_LDA(At, 1, 0); PG8_STAGE(PG8_SA(0, 1), a2 + hstep, voffA);
            PG8_WAIT_L(8); PG8_BAR; PG8_WAIT_L(0); PG8_MMA(0, 0, At, B0); PG8_BAR; PG8_SCHED;
            PG8_LDB(B1, 1, 1); PG8_STAGE(PG8_SB(1, 0), b3, voffB);
            PG8_BAR; PG8_WAIT_L(0); PG8_MMA(0, 1, At, B1); PG8_BAR;
            PG8_LDA(At, 1, 1); PG8_STAGE(PG8_SA(1, 0), a3, voffA);
            PG8_BAR; PG8_WAIT_L(0); PG8_MMA(1, 0, At, B0); PG8_BAR; PG8_SCHED;
            PG8_STAGE(PG8_SB(1, 1), b3 + hstep, voffB);
            PG8_WAIT_V(6); PG8_BAR; PG8_MMA(1, 1, At, B1); PG8_BAR;
            }
        }
        if constexpr (ALIGN_EPI) { if (wr == 0) PG8_BAR; }
        const bool keep = E(acc, cur, wr, wc, fr, fq);
        if (!has_next) break;
        if (!(Epi::CHAIN && keep)) {
#pragma unroll
            for (int a = 0; a < 2; ++a)
#pragma unroll
                for (int b = 0; b < 2; ++b)
#pragma unroll
                    for (int m = 0; m < 4; ++m)
#pragma unroll
                        for (int n = 0; n < 2; ++n) acc[a][b][m][n] = (f32x4){0.f, 0.f, 0.f, 0.f};
        }
        cur = nxt; cA = nA; cB = nB; ++ui;
        if constexpr (ALIGN_EPI) { if (wr == 1) PG8_BAR; }
    }
    PG8_WAIT_V(0);
    if constexpr (!ALIGN_EPI) { if (wr == 0) PG8_BAR; }
    PG8_BAR;
#undef PG8_SA
#undef PG8_SB
#undef PG8_STAGE
#undef PG8_LDA
#undef PG8_LDB
#undef PG8_MMA
#undef PG8_WAIT_V
#undef PG8_WAIT_L
#undef PG8_BAR
#undef PG8_SCHED
}
}
constexpr int NWAVES = 8;
constexpr int RING_OFF = 0, RING_BYTES = 131072;
constexpr int LDSCTL_OFF = RING_BYTES, MISC_OFF = LDSCTL_OFF + 320;
constexpr int LDS_BYTES = 147456;
constexpr int CW_TMO = 0, CW_CODE = 1;
constexpr int CW_BAR = 4096;
#define GAS __attribute__((address_space(1)))
#define LAS __attribute__((address_space(3)))
typedef unsigned v4u __attribute__((ext_vector_type(4)));
typedef float f32x4 __attribute__((ext_vector_type(4)));
typedef GAS unsigned gu32;
#define RLX_AGENT __ATOMIC_RELAXED, __HIP_MEMORY_SCOPE_AGENT
#define LDS_WAIT() asm volatile("s_waitcnt lgkmcnt(0)" ::: "memory")
#define VM_WAIT() asm volatile("s_waitcnt vmcnt(0)" ::: "memory")
__device__ __forceinline__ unsigned pk2(float lo, float hi) { return (unsigned)f2bf(lo) | ((unsigned)f2bf(hi) << 16); }

#define XB_TMO      128
#define XB_XCNT(j)  (256  + 64 * (j))
#define XB_XSUB(j)  (1280 + 64 * (j))
#define XB_XGEN(j)  (2304 + 64 * (j))
#define XB_TOP      3328
#define XB_TOPGEN   3392
#define XCD_BAR_WORDS 3456
#define XB_SPIN_CAP (1u << 18)
__device__ __forceinline__ unsigned xb_ld(unsigned* p)              { return __hip_atomic_load(p, __ATOMIC_RELAXED, __HIP_MEMORY_SCOPE_AGENT); }
__device__ __forceinline__ unsigned xb_add(unsigned* p, unsigned v) { return __hip_atomic_fetch_add(p, v, __ATOMIC_RELAXED, __HIP_MEMORY_SCOPE_AGENT); }
__device__ __forceinline__ unsigned xb_xcc_id() { return (unsigned)__builtin_amdgcn_s_getreg((3 << 11) | 20) & 0xFu; }
#define XB_SPIN(cond, bar) do { unsigned _sp = 0; while (cond) { __builtin_amdgcn_s_sleep(1); \
    if ((++_sp & 255u) == 0u) { if (xb_ld(&(bar)[XB_TMO])) break; if (_sp > XB_SPIN_CAP) { atomicAdd(&(bar)[XB_TMO], 1u); break; } } } } while (0)
struct XcdBarrier { unsigned* bar; unsigned x; volatile LAS unsigned* st; };
__device__ __forceinline__ XcdBarrier xcd_barrier_post(unsigned* bar, volatile LAS unsigned* st) {
    XcdBarrier b; b.bar = bar; b.x = xb_xcc_id(); b.st = st;
    if (threadIdx.x == 0) (void)xb_add(&bar[XB_XCNT(b.x)], 1u);
    return b;
}
__device__ __forceinline__ void xcd_barrier_complete(unsigned* bar, unsigned x, unsigned& nloc, unsigned& nx) {
    const unsigned G = gridDim.x * gridDim.y * gridDim.z;
    unsigned sum, cnt, mine, sp = 0u;
    for (;;) {
        sum = 0u; cnt = 0u; mine = 0u;
#pragma unroll
        for (unsigned j = 0; j < 16; ++j) { const unsigned c = xb_ld(&bar[XB_XCNT(j)]); sum += c; cnt += (c > 0u) ? 1u : 0u; mine = (j == x) ? c : mine; }
        if (sum == G) break;
        __builtin_amdgcn_s_sleep(1);
        if ((++sp & 255u) == 0u) { if (xb_ld(&bar[XB_TMO])) break; if (sp > XB_SPIN_CAP) { atomicAdd(&bar[XB_TMO], 1u); break; } }
    }
    nloc = mine > 0u ? mine : 1u; nx = cnt > 0u ? cnt : 1u;
}
__device__ __forceinline__ void xcd_barrier(const XcdBarrier& b) {
    asm volatile("s_waitcnt vmcnt(0)" ::: "memory");
    __syncthreads();
    if (threadIdx.x == 0) {
        unsigned* bar = b.bar;
        __builtin_amdgcn_s_waitcnt(0);
        unsigned nloc = b.st[0], nx = b.st[1];
        if (nloc == 0u) { xcd_barrier_complete(bar, b.x, nloc, nx); b.st[0] = nloc; b.st[1] = nx; }
        const unsigned old = xb_add(&bar[XB_XSUB(b.x)], 1u);
        const unsigned gen = old / nloc;
        if (old + 1u == (gen + 1u) * nloc) {
            __builtin_amdgcn_fence(__ATOMIC_RELEASE, "agent");
            asm volatile("s_waitcnt vmcnt(0)" ::: "memory");
            const unsigned og = xb_add(&bar[XB_TOP], 1u);
            const unsigned tg = og / nx;
            if (og + 1u == (tg + 1u) * nx) xb_add(&bar[XB_TOPGEN], 1u);
            else XB_SPIN(xb_ld(&bar[XB_TOPGEN]) == tg, bar);
            __builtin_amdgcn_fence(__ATOMIC_ACQUIRE, "agent");
            xb_add(&bar[XB_XGEN(b.x)], 1u);
            asm volatile("s_waitcnt vmcnt(0)" ::: "memory");
        } else {
            XB_SPIN(xb_ld(&bar[XB_XGEN(b.x)]) == gen, bar);
            __builtin_amdgcn_fence(__ATOMIC_ACQUIRE, "agent");
            asm volatile("s_waitcnt vmcnt(0)" ::: "memory");
        }
    }
    __syncthreads();
}

struct Args {
    const float *x, *g_mix_pre, *g_mix_post, *g_ffn_pre, *g_ffn_post, *w_in, *b_in, *lb_logits, *hg_norm, *ml_conv_w, *ml_conv_b, *ml_norm, *w_up_a, *w_up_b, *w_out, *ffn_w_gate, *ffn_w_up,
        *ffn_conv_w, *ffn_conv_b, *ffn_w_down;
    float* out; unsigned char* ws;
    int ph_lo, ph_hi, li, pad;
};
struct Frame { LAS unsigned char* lds; int tid, lane, wave, vcu, G; };

template <int IL = 0>
__device__ __forceinline__ void transpose_item(const float* W, int K, int ldw, int nblk, int gap_at, bf16_t* WT, LAS float* scr, int item, int lane) {
    const int kb = item / nblk, nb = item % nblk, k0 = 64 * kb, n0 = 32 * nb, ns = n0 + (n0 >= gap_at ? 8 : 0);
    const int dr0 = IL == 0 ? n0 : 256 * (n0 >> 7) + (n0 & 127) + (IL == 2 ? 128 : 0);
#pragma unroll 8
    for (int i = 0; i < 32; ++i) { const int kk = 2 * i + (lane >> 5); scr[kk * 33 + (lane & 31)] = W[(size_t)(k0 + kk) * ldw + ns + (lane & 31)]; }
    LDS_WAIT(); asm volatile("" ::: "memory");
    const int c = lane & 7;
#pragma unroll
    for (int j = 0; j < 4; ++j) { const int n = (lane >> 3) + 8 * j; const LAS float* s = scr + (8 * c) * 33 + n;
        v4u o; o.x = pk2(s[0 * 33], s[1 * 33]); o.y = pk2(s[2 * 33], s[3 * 33]); o.z = pk2(s[4 * 33], s[5 * 33]); o.w = pk2(s[6 * 33], s[7 * 33]);
        *(GAS v4u*)(WT + (size_t)(dr0 + n) * K + k0 + 8 * c) = o; }
    LDS_WAIT(); asm volatile("" ::: "memory");
}
__device__ __forceinline__ void prep_row(const Args& a, const LAS float* w8t, int row, int lane) {
    asm volatile("" ::: "memory");
    const float4* xr = (const float4*)(a.x + (size_t)row * D_MODEL);
    bf16_t* HB = (bf16_t*)(a.ws + WS_HB); float* GATES = (float*)(a.ws + WS_GATES);
    float4 v[8]; float ss = 0.f;
#pragma unroll
    for (int j = 0; j < 8; ++j) { v[j] = xr[lane + 64 * j]; ss += v[j].x * v[j].x + v[j].y * v[j].y + v[j].z * v[j].z + v[j].w * v[j].w; }
    ss = wave_sum(ss);
    const float r = 1.f / sqrtf(ss * (1.f / D_MODEL) + EPS);
    float g[8];
#pragma unroll
    for (int q = 0; q < 8; ++q) g[q] = 0.f;
#pragma unroll
    for (int j = 0; j < 8; ++j) {
        const int d0 = (lane + 64 * j) * 4;
        const float4 gn = *(const float4*)(a.g_mix_pre + d0);
        const float h0 = v[j].x * r * gn.x, h1 = v[j].y * r * gn.y, h2 = v[j].z * r * gn.z, h3 = v[j].w * r * gn.w;
        uint2 o; o.x = pk2(h0, h1); o.y = pk2(h2, h3);
        *(uint2*)(HB + (size_t)row * D_MODEL + d0) = o;
#pragma unroll
        for (int q = 0; q < 8; ++q) { const f32x4 w = *(const LAS f32x4*)(w8t + q * 2048 + d0); g[q] += (h0 * w[0] + h1 * w[1]) + (h2 * w[2] + h3 * w[3]); }
        asm volatile("" ::: "memory");
    }
#pragma unroll
    for (int q = 0; q < 8; ++q) g[q] = wave_sum(g[q]);
    if (lane == 0) {
#pragma unroll
        for (int q = 0; q < 8; ++q) GATES[(size_t)row * 8 + q] = g[q] + a.b_in[C_IG + q];
    }
}
__device__ __forceinline__ void phase_prep(const Args& a, const Frame& F) {
    LAS float* scr = (LAS float*)(F.lds + RING_OFF + F.wave * 16384);
    const int gw = F.vcu * NWAVES + F.wave, NGW = F.G * NWAVES;
    constexpr int I_IN = (2048 / 64) * (11264 / 32), I_A = (1024 / 64) * (2048 / 32), I_O = (2048 / 64) * (2048 / 32);
    constexpr int NITEMS = I_IN + 2 * I_A + I_O;
    for (int it = gw; it < NITEMS; it += NGW) {
        int r = it;
        if (r < I_IN) { transpose_item(a.w_in, 2048, IN_W, 11264 / 32, 7168, (bf16_t*)(a.ws + WS_WINT), scr, r, F.lane); continue; } r -= I_IN;
        if (r < I_A) { transpose_item(a.w_up_a, 1024, 2048, 2048 / 32, 1 << 30, (bf16_t*)(a.ws + WS_WA), scr, r, F.lane); continue; } r -= I_A;
        if (r < I_A) { transpose_item(a.w_up_b, 1024, 2048, 2048 / 32, 1 << 30, (bf16_t*)(a.ws + WS_WB), scr, r, F.lane); continue; } r -= I_A;
        transpose_item(a.w_out, 2048, 2048, 2048 / 32, 1 << 30, (bf16_t*)(a.ws + WS_WOUT), scr, r, F.lane);
    }
    __syncthreads();
    LAS float* w8t = (LAS float*)(F.lds + RING_OFF);
    for (int d = F.tid; d < D_MODEL; d += NWAVES * 64) { const float4* wr = (const float4*)(a.w_in + (size_t)d * IN_W + C_IG); const float4 w0 = wr[0], w1 = wr[1];
        w8t[0 * 2048 + d] = w0.x; w8t[1 * 2048 + d] = w0.y; w8t[2 * 2048 + d] = w0.z; w8t[3 * 2048 + d] = w0.w; w8t[4 * 2048 + d] = w1.x; w8t[5 * 2048 + d] = w1.y; w8t[6 * 2048 + d] = w1.z; w8t[7 * 2048 + d] = w1.w; }
    __syncthreads();
    for (int m = gw; m < M_TOK; m += NGW) prep_row(a, w8t, m, F.lane);
    if (gw < 16) { const int c = gw * 64 + F.lane; const float l0 = a.lb_logits[c], l1 = a.lb_logits[HG_W + c], mx = fmaxf(l0, l1); const float e0 = expf(l0 - mx), e1 = expf(l1 - mx); ((float*)(a.ws + WS_LB))[c] = e0 / (e0 + e1); }
}
__device__ __forceinline__ void phase_ffn_weights(const Args& a, const Frame& F) {
    LAS float* scr = (LAS float*)(F.lds + RING_OFF + F.wave * 16384);
    const int gw = F.vcu * NWAVES + F.wave, NGW = F.G * NWAVES;
    constexpr int I_G = (2048 / 64) * (D_FF / 32), I_D = (D_FF / 64) * (2048 / 32);
    for (int it = gw; it < 2 * I_G + I_D; it += NGW) {
        int r = it;
        if (r < I_G) { transpose_item<1>(a.ffn_w_gate, 2048, D_FF, D_FF / 32, 1 << 30, (bf16_t*)(a.ws + WS_WG), scr, r, F.lane); continue; } r -= I_G;
        if (r < I_G) { transpose_item<2>(a.ffn_w_up, 2048, D_FF, D_FF / 32, 1 << 30, (bf16_t*)(a.ws + WS_WG), scr, r, F.lane); continue; } r -= I_G;
        transpose_item(a.ffn_w_down, D_FF, 2048, 2048 / 32, 1 << 30, (bf16_t*)(a.ws + WS_WD), scr, r, F.lane);
    }
}

__device__ __forceinline__ void stageF_row(const Args& a, int row, int lane) {
    const float4* mr = (const float4*)((const float*)(a.ws + WS_MIX) + (size_t)row * D_MODEL); const float4* xr = (const float4*)(a.x + (size_t)row * D_MODEL);
    bf16_t* H2 = (bf16_t*)(a.ws + WS_H2);
    float4 v[8]; float ss = 0.f;
#pragma unroll
    for (int j = 0; j < 8; ++j) { v[j] = mr[lane + 64 * j]; ss += v[j].x * v[j].x + v[j].y * v[j].y + v[j].z * v[j].z + v[j].w * v[j].w; }
    ss = wave_sum(ss);
    const float r = 1.f / sqrtf(ss * (1.f / D_MODEL) + EPS);
    float s2 = 0.f;
#pragma unroll
    for (int j = 0; j < 8; ++j) {
        const float4 gp = *(const float4*)(a.g_mix_post + (lane + 64 * j) * 4); const float4 xv = xr[lane + 64 * j];
        v[j].x = xv.x + v[j].x * r * gp.x; v[j].y = xv.y + v[j].y * r * gp.y; v[j].z = xv.z + v[j].z * r * gp.z; v[j].w = xv.w + v[j].w * r * gp.w;
        s2 += v[j].x * v[j].x + v[j].y * v[j].y + v[j].z * v[j].z + v[j].w * v[j].w;
        ((float4*)(a.out + (size_t)row * D_MODEL))[lane + 64 * j] = v[j];
    }
    s2 = wave_sum(s2);
    const float r2 = 1.f / sqrtf(s2 * (1.f / D_MODEL) + EPS);
#pragma unroll
    for (int j = 0; j < 8; ++j) {
        const float4 g2 = *(const float4*)(a.g_ffn_pre + (lane + 64 * j) * 4);
        uint2 o; o.x = pk2(v[j].x * r2 * g2.x, v[j].y * r2 * g2.y); o.y = pk2(v[j].z * r2 * g2.z, v[j].w * r2 * g2.w);
        *(uint2*)(H2 + (size_t)row * D_MODEL + (lane + 64 * j) * 4) = o;
    }
}
__device__ __forceinline__ void stageJ_row(const Args& a, int row, int lane) {
    const float4* fr = (const float4*)((const float*)(a.ws + WS_FFN) + (size_t)row * D_MODEL); float4* orow = (float4*)(a.out + (size_t)row * D_MODEL);
    float4 v[8]; float ss = 0.f;
#pragma unroll
    for (int j = 0; j < 8; ++j) { v[j] = fr[lane + 64 * j]; ss += v[j].x * v[j].x + v[j].y * v[j].y + v[j].z * v[j].z + v[j].w * v[j].w; }
    ss = wave_sum(ss);
    const float r = 1.f / sqrtf(ss * (1.f / D_MODEL) + EPS);
#pragma unroll
    for (int j = 0; j < 8; ++j) {
        const float4 gp = *(const float4*)(a.g_ffn_post + (lane + 64 * j) * 4); float4 xv = orow[lane + 64 * j];
        xv.x += v[j].x * r * gp.x; xv.y += v[j].y * r * gp.y; xv.z += v[j].z * r * gp.z; xv.w += v[j].w * r * gp.w;
        orow[lane + 64 * j] = xv;
    }
}
__device__ __forceinline__ float fast_gelu_tanh(float x) {
    const float u2 = 1.5957691216057308f * (x + 0.044715f * x * x * x);
    return x * __builtin_amdgcn_rcpf(1.f + __builtin_amdgcn_exp2f(-1.4426950408889634f * u2));
}
__device__ __forceinline__ void phase_H(const Args& a, const Frame& F) {
    const bf16_t* GRAW = (const bf16_t*)(a.ws + WS_GRAW); bf16_t* UP = (bf16_t*)(a.ws + WS_UP);
    constexpr int CG = D_FF / 8;
    const size_t total = (size_t)M_TOK * CG, stride = (size_t)F.G * 512;
    for (size_t i = (size_t)F.vcu * 512 + F.tid; i < total; i += stride) {
        const int row = (int)(i / CG), cg = (int)(i % CG), c0 = cg * 8, t = row % SEQ;
        float acc[8];
        { const float4 b0 = *(const float4*)(a.ffn_conv_b + c0), b1 = *(const float4*)(a.ffn_conv_b + c0 + 4); acc[0] = b0.x; acc[1] = b0.y; acc[2] = b0.z; acc[3] = b0.w; acc[4] = b1.x; acc[5] = b1.y; acc[6] = b1.z; acc[7] = b1.w; }
#pragma unroll
        for (int j = 0; j < 3; ++j) {
            const int tt = t - 2 + j;
            if (tt >= 0) {
                const v4u g = *(const v4u*)(GRAW + (size_t)(row - 2 + j) * D_FF + c0);
                const float4 w0 = *(const float4*)(a.ffn_conv_w + (size_t)j * D_FF + c0), w1 = *(const float4*)(a.ffn_conv_w + (size_t)j * D_FF + c0 + 4);
                acc[0] += w0.x * __uint_as_float(g.x << 16); acc[1] += w0.y * __uint_as_float(g.x & 0xffff0000u);
                acc[2] += w0.z * __uint_as_float(g.y << 16); acc[3] += w0.w * __uint_as_float(g.y & 0xffff0000u);
                acc[4] += w1.x * __uint_as_float(g.z << 16); acc[5] += w1.y * __uint_as_float(g.z & 0xffff0000u);
                acc[6] += w1.z * __uint_as_float(g.w << 16); acc[7] += w1.w * __uint_as_float(g.w & 0xffff0000u);
            }
        }
        v4u* up = (v4u*)(UP + (size_t)row * D_FF + c0); const v4u u = *up;
        const float uu[8] = {__uint_as_float(u.x << 16), __uint_as_float(u.x & 0xffff0000u), __uint_as_float(u.y << 16), __uint_as_float(u.y & 0xffff0000u),
                             __uint_as_float(u.z << 16), __uint_as_float(u.z & 0xffff0000u), __uint_as_float(u.w << 16), __uint_as_float(u.w & 0xffff0000u)};
        v4u o;
        o.x = pk2(fast_gelu_tanh(acc[0]) * uu[0], fast_gelu_tanh(acc[1]) * uu[1]); o.y = pk2(fast_gelu_tanh(acc[2]) * uu[2], fast_gelu_tanh(acc[3]) * uu[3]);
        o.z = pk2(fast_gelu_tanh(acc[4]) * uu[4], fast_gelu_tanh(acc[5]) * uu[5]); o.w = pk2(fast_gelu_tanh(acc[6]) * uu[6], fast_gelu_tanh(acc[7]) * uu[7]);
        *up = o;
    }
}

__device__ __forceinline__ void geglu_fixup(const Args& a, int pm, int tid) {
    if ((pm & 7) == 0) return;
    const float* GT = (const float*)(a.ws + WS_GTAIL) + (size_t)(pm - 1) * 2 * D_FF; const float* GH = (const float*)(a.ws + WS_GHEAD) + (size_t)pm * 2 * D_FF; const float* UH = (const float*)(a.ws + WS_UHEAD) + (size_t)pm * 2 * D_FF;
    bf16_t* ACT = (bf16_t*)(a.ws + WS_UP) + (size_t)pm * 256 * D_FF;
    for (int i = tid; i < D_FF / 4; i += NWAVES * 64) {
        const int f = 4 * i;
        const f32x4 gm2 = *(const f32x4*)(GT + f), gm1 = *(const f32x4*)(GT + D_FF + f), g0 = *(const f32x4*)(GH + f), g1 = *(const f32x4*)(GH + D_FF + f), u0 = *(const f32x4*)(UH + f), u1 = *(const f32x4*)(UH + D_FF + f);
        const f32x4 w0 = *(const f32x4*)(a.ffn_conv_w + f), w1 = *(const f32x4*)(a.ffn_conv_w + D_FF + f), w2 = *(const f32x4*)(a.ffn_conv_w + 2 * D_FF + f), bv = *(const f32x4*)(a.ffn_conv_b + f);
        float r0[4], r1[4];
#pragma unroll
        for (int j = 0; j < 4; ++j) { r0[j] = pg8::gelu_tanh_fast(bv[j] + ((w0[j] * gm2[j] + w1[j] * gm1[j]) + w2[j] * g0[j])) * u0[j]; r1[j] = pg8::gelu_tanh_fast(bv[j] + ((w0[j] * gm1[j] + w1[j] * g0[j]) + w2[j] * g1[j])) * u1[j]; }
        uint2 o0, o1; o0.x = pk2(r0[0], r0[1]); o0.y = pk2(r0[2], r0[3]); o1.x = pk2(r1[0], r1[1]); o1.y = pk2(r1[2], r1[3]);
        *(uint2*)(ACT + f) = o0; *(uint2*)(ACT + D_FF + f) = o1;
    }
}
namespace rc {
typedef short bf16x8 __attribute__((ext_vector_type(8)));
typedef float f32x4 __attribute__((ext_vector_type(4)));
typedef unsigned v2u __attribute__((ext_vector_type(2)));
constexpr size_t WS_DSH = 2 * MiB;
constexpr size_t WS_DCM = 34 * MiB;
constexpr size_t WS_DECH = 66 * MiB;
constexpr size_t WS_DNM = 67 * MiB;
constexpr size_t WS_DECM = 68 * MiB;
constexpr int LQ = 0;
constexpr int LK = 64 * 272;
constexpr int LVT = 2 * 64 * 272;
constexpr int LAT = LVT + 256 * 144;
constexpr int LKT = LAT + 64 * 144;
constexpr int LRED = LKT + 128 * 144;
constexpr int LSC = LRED + 4096;
static_assert(LSC + 1024 <= RING_BYTES, "recurrence LDS map");

__device__ __forceinline__ unsigned pk2f(float lo, float hi) { return pg8::cvt_pk_bf16(lo, hi); }
__device__ __forceinline__ float bflo(unsigned u) { return __uint_as_float(u << 16); }
__device__ __forceinline__ float bfhi(unsigned u) { return __uint_as_float(u & 0xffff0000u); }
#define RC_BAR() do { asm volatile("s_waitcnt vmcnt(0) lgkmcnt(0)" ::: "memory"); __builtin_amdgcn_s_barrier(); asm volatile("" ::: "memory"); } while (0)
#define RC_MFMA(a, b, c) __builtin_amdgcn_mfma_f32_16x16x32_bf16(a, b, c, 0, 0, 0)

template <int NE>
__device__ __forceinline__ void load_vT(LAS unsigned char* lds, const bf16_t* V, int tid) {
    constexpr int NOCT = NE / 8;
#pragma unroll
    for (int j = 0; j < (64 * NOCT) / 512; ++j) {
        const int idx = tid + 512 * j, t = idx / NOCT, eo = idx % NOCT;
        const v4u w = *(const v4u*)(V + (size_t)t * 1024 + eo * 8);
        LAS unsigned short* dst = (LAS unsigned short*)(lds + LVT + (eo * 8) * 144 + t * 2);
        dst[0 * 72] = (unsigned short)(w.x & 0xffffu); dst[1 * 72] = (unsigned short)(w.x >> 16); dst[2 * 72] = (unsigned short)(w.y & 0xffffu); dst[3 * 72] = (unsigned short)(w.y >> 16);
        dst[4 * 72] = (unsigned short)(w.z & 0xffffu); dst[5 * 72] = (unsigned short)(w.z >> 16); dst[6 * 72] = (unsigned short)(w.w & 0xffffu); dst[7 * 72] = (unsigned short)(w.w >> 16);
    }
}
__device__ __forceinline__ void hg_cumsum(LAS unsigned char* lds, const float* LOGFp  , int tid, float (&lf)[16], float (&bb)[16], float& total) {
    const int d = tid & 127, tq = tid >> 7;
    LAS float* part = (LAS float*)(lds + LRED);
#pragma unroll
    for (int i = 0; i < 16; ++i) lf[i] = LOGFp[(size_t)(16 * tq + i) * 1024 + d];
    float c = 0.f;
#pragma unroll
    for (int i = 0; i < 16; ++i) { c += lf[i]; bb[i] = c; }
    part[tq * 128 + d] = c;
    RC_BAR();
    const float p0 = part[d], p1 = part[128 + d], p2 = part[256 + d], p3 = part[384 + d];
    const float prefix = tq == 0 ? 0.f : tq == 1 ? p0 : tq == 2 ? p0 + p1 : p0 + p1 + p2;
    total = (p0 + p1) + (p2 + p3);
#pragma unroll
    for (int i = 0; i < 16; ++i) bb[i] += prefix;
}

__device__ __forceinline__ void hg_L(const Args& a, LAS unsigned char* lds, int item, int tid) {
    const int bh = item >> 5, n = item & 31, b = bh >> 3, h = bh & 7, row0 = b * SEQ + n * 64, col0 = h * 128;
    const int lane = tid & 63, w = __builtin_amdgcn_readfirstlane(tid >> 6), fr = lane & 15, fq = lane >> 4;
    float lf[16], bb[16], total;
    hg_cumsum(lds, (const float*)(a.ws + WS_LOGF) + (size_t)row0 * 1024 + col0, tid, lf, bb, total);
    {
        const int d = tid & 127, tq = tid >> 7;
        unsigned pk[8];
#pragma unroll
        for (int i = 0; i < 8; ++i) {
            const float k0 = (1.f - __expf(lf[2 * i])) * __expf(total - bb[2 * i]), k1 = (1.f - __expf(lf[2 * i + 1])) * __expf(total - bb[2 * i + 1]);
            pk[i] = pk2f(k0, k1);
        }
        LAS v4u* dst = (LAS v4u*)(lds + LKT + d * 144 + tq * 32);
        dst[0] = (v4u){pk[0], pk[1], pk[2], pk[3]}; dst[1] = (v4u){pk[4], pk[5], pk[6], pk[7]};
        if (tq == 0) ((float*)(a.ws + WS_DECH))[(size_t)(bh * 32 + n) * 128 + d] = __expf(total);
    }
    load_vT<128>(lds, (const bf16_t*)(a.ws + WS_VH) + (size_t)row0 * 1024 + col0, tid);
    RC_BAR();
    {
        bf16x8 fe[2];
#pragma unroll
        for (int ks = 0; ks < 2; ++ks) fe[ks] = *(const LAS bf16x8*)(lds + LVT + (16 * w + fr) * 144 + (8 * fq + 32 * ks) * 2);
        bf16_t* out = (bf16_t*)(a.ws + WS_DSH) + ((size_t)(bh * 32 + n) * 128 + 16 * w + fr) * 128 + 4 * fq;
#pragma unroll
        for (int dt = 0; dt < 8; ++dt) {
            f32x4 acc = (f32x4){0.f, 0.f, 0.f, 0.f};
#pragma unroll
            for (int ks = 0; ks < 2; ++ks) { const bf16x8 fd = *(const LAS bf16x8*)(lds + LKT + (16 * dt + fr) * 144 + (8 * fq + 32 * ks) * 2); acc = RC_MFMA(fd, fe[ks], acc); }
            uint2 o; o.x = pk2f(acc[0], acc[1]); o.y = pk2f(acc[2], acc[3]);
            *(uint2*)(out + 16 * dt) = o;
        }
    }
    RC_BAR();
}
__device__ __forceinline__ void hg_O(const Args& a, LAS unsigned char* lds, int item, int tid) {
    const int bh = item >> 5, n = item & 31, b = bh >> 3, h = bh & 7, row0 = b * SEQ + n * 64, col0 = h * 128;
    const int lane = tid & 63, w = __builtin_amdgcn_readfirstlane(tid >> 6), fr = lane & 15, fq = lane >> 4;
    float lf[16], bb[16], total;
    hg_cumsum(lds, (const float*)(a.ws + WS_LOGF) + (size_t)row0 * 1024 + col0, tid, lf, bb, total);
    {
        const int d = tid & 127, tq = tid >> 7;
        const bf16_t* qp = (const bf16_t*)(a.ws + WS_QH) + (size_t)(row0 + 16 * tq) * 1024 + col0 + d;
        LAS unsigned short* lq = (LAS unsigned short*)(lds + LQ + (16 * tq) * 272 + d * 2);
        LAS unsigned short* lk = (LAS unsigned short*)(lds + LK + (16 * tq) * 272 + d * 2);
#pragma unroll
        for (int i = 0; i < 16; ++i) {
            const float q = bf2f(qp[(size_t)i * 1024]);
            const float eb = __expf(bb[i]);
            const float qd = q * eb, ki = (1.f - __expf(lf[i])) * __builtin_amdgcn_rcpf(eb);
            const unsigned p = pk2f(qd, ki);
            lq[i * 136] = (unsigned short)(p & 0xffffu); lk[i * 136] = (unsigned short)(p >> 16);
        }
    }
    load_vT<128>(lds, (const bf16_t*)(a.ws + WS_VH) + (size_t)row0 * 1024 + col0, tid);
    RC_BAR();
    {
        const int tt = w >> 1;
        bf16x8 fqv[4];
#pragma unroll
        for (int ks = 0; ks < 4; ++ks) fqv[ks] = *(const LAS bf16x8*)(lds + LQ + (16 * tt + fr) * 272 + (8 * fq + 32 * ks) * 2);
#pragma unroll
        for (int j = 0; j < 2; ++j) {
            const int st = 2 * (w & 1) + j;
            f32x4 acc = (f32x4){0.f, 0.f, 0.f, 0.f};
            if (st <= tt) {
#pragma unroll
                for (int ks = 0; ks < 4; ++ks) { const bf16x8 fk = *(const LAS bf16x8*)(lds + LK + (16 * st + fr) * 272 + (8 * fq + 32 * ks) * 2); acc = RC_MFMA(fk, fqv[ks], acc); }
                if (st == tt) {
#pragma unroll
                    for (int r = 0; r < 4; ++r) if (4 * fq + r > fr) acc[r] = 0.f;
                }
            }
            v2u o; o.x = pk2f(acc[0], acc[1]); o.y = pk2f(acc[2], acc[3]);
            *(LAS v2u*)(lds + LAT + (16 * tt + fr) * 144 + (16 * st + 4 * fq) * 2) = o;
        }
    }
    RC_BAR();
    {
        bf16x8 fv[2], fs[4];
        const bf16_t* sp = (const bf16_t*)(a.ws + WS_DSH) + ((size_t)(bh * 32 + n) * 128 + 16 * w + fr) * 128 + 8 * fq;
#pragma unroll
        for (int ks = 0; ks < 4; ++ks) fs[ks] = *(const bf16x8*)(sp + 32 * ks);
#pragma unroll
        for (int ks = 0; ks < 2; ++ks) fv[ks] = *(const LAS bf16x8*)(lds + LVT + (16 * w + fr) * 144 + (8 * fq + 32 * ks) * 2);
        f32x4 acc[4];
#pragma unroll
        for (int tt = 0; tt < 4; ++tt) {
            acc[tt] = (f32x4){0.f, 0.f, 0.f, 0.f};
#pragma unroll
            for (int ks = 0; ks < 2; ++ks) { const bf16x8 fa = *(const LAS bf16x8*)(lds + LAT + (16 * tt + fr) * 144 + (8 * fq + 32 * ks) * 2); acc[tt] = RC_MFMA(fv[ks], fa, acc[tt]); }
#pragma unroll
            for (int ks = 0; ks < 4; ++ks) { const bf16x8 fqd = *(const LAS bf16x8*)(lds + LQ + (16 * tt + fr) * 272 + (8 * fq + 32 * ks) * 2); acc[tt] = RC_MFMA(fs[ks], fqd, acc[tt]); }
        }
        LAS float* red = (LAS float*)(lds + LRED);
#pragma unroll
        for (int tt = 0; tt < 4; ++tt) {
            float s = (acc[tt][0] * acc[tt][0] + acc[tt][1] * acc[tt][1]) + (acc[tt][2] * acc[tt][2] + acc[tt][3] * acc[tt][3]);
            s += __shfl_xor(s, 16); s += __shfl_xor(s, 32);
            if (fq == 0) red[(16 * tt + fr) * 8 + w] = s;
        }
        RC_BAR();
        const f32x4 gn = *(const f32x4*)(a.hg_norm + col0 + 16 * w + 4 * fq);
#pragma unroll
        for (int tt = 0; tt < 4; ++tt) {
            const int t = 16 * tt + fr;
            const f32x4 r0 = *(const LAS f32x4*)(red + t * 8), r1 = *(const LAS f32x4*)(red + t * 8 + 4);
            const float ss = ((r0[0] + r0[1]) + (r0[2] + r0[3])) + ((r1[0] + r1[1]) + (r1[2] + r1[3]));
            const float rn = 1.f / sqrtf(ss * (1.f / 128.f) + EPS);
            const size_t off = (size_t)(row0 + t) * 1024 + col0 + 16 * w + 4 * fq;
            const uint2 g = *(const uint2*)((const bf16_t*)(a.ws + WS_GH) + off);
            uint2 o;
            o.x = pk2f(acc[tt][0] * rn * gn[0] * bflo(g.x), acc[tt][1] * rn * gn[1] * bfhi(g.x));
            o.y = pk2f(acc[tt][2] * rn * gn[2] * bflo(g.y), acc[tt][3] * rn * gn[3] * bfhi(g.y));
            *(uint2*)((bf16_t*)(a.ws + WS_YA) + off) = o;
        }
    }
    RC_BAR();
}

__device__ __forceinline__ float log_sigmoid_f(float x) { return fminf(x, 0.f) - log1pf(expf(-fabsf(x))); }
__device__ __forceinline__ float ml_scalars(const Args& a, LAS unsigned char* lds, int row0, int h, int lane) {
    const float* G = (const float*)(a.ws + WS_GATES) + (size_t)(row0 + lane) * 8;
    const float ig = G[h], fg = G[4 + h];
    float bsum = log_sigmoid_f(fg);
#pragma unroll
    for (int o = 1; o < 64; o <<= 1) { const float up = __shfl_up(bsum, o); if (lane >= o) bsum += up; }
    const float bl = __shfl(bsum, 63);
    const float kscale = 0.08838834764831845f;
    LAS float* sc = (LAS float*)(lds + LSC);
    sc[lane] = expf(bsum); sc[64 + lane] = kscale * expf(ig - bsum); sc[128 + lane] = kscale * expf(bl - bsum + ig);
    return expf(bl);
}
template <int NT>
__device__ __forceinline__ void ml_conv8(const Args& a, const bf16_t* MQK, int rowbase  , int tseq0  , int tl0  , int c0, float (&out)[NT][8]) {
    float x[NT + 3][8];
#pragma unroll
    for (int r = 0; r < NT + 3; ++r) {
        const int tl = tl0 - 3 + r;
        if (tseq0 + tl >= 0) { const v4u w = *(const v4u*)(MQK + (size_t)(rowbase + tl) * 1024 + c0);
            x[r][0] = bflo(w.x); x[r][1] = bfhi(w.x); x[r][2] = bflo(w.y); x[r][3] = bfhi(w.y); x[r][4] = bflo(w.z); x[r][5] = bfhi(w.z); x[r][6] = bflo(w.w); x[r][7] = bfhi(w.w); }
        else {
#pragma unroll
            for (int c = 0; c < 8; ++c) x[r][c] = 0.f; }
    }
    float wj[4][8], bj[8];
#pragma unroll
    for (int j = 0; j < 4; ++j) { const f32x4 w0 = *(const f32x4*)(a.ml_conv_w + j * 1024 + c0), w1 = *(const f32x4*)(a.ml_conv_w + j * 1024 + c0 + 4);
        wj[j][0] = w0[0]; wj[j][1] = w0[1]; wj[j][2] = w0[2]; wj[j][3] = w0[3]; wj[j][4] = w1[0]; wj[j][5] = w1[1]; wj[j][6] = w1[2]; wj[j][7] = w1[3]; }
    { const f32x4 b0 = *(const f32x4*)(a.ml_conv_b + c0), b1 = *(const f32x4*)(a.ml_conv_b + c0 + 4); bj[0] = b0[0]; bj[1] = b0[1]; bj[2] = b0[2]; bj[3] = b0[3]; bj[4] = b1[0]; bj[5] = b1[1]; bj[6] = b1[2]; bj[7] = b1[3]; }
#pragma unroll
    for (int i = 0; i < NT; ++i)
#pragma unroll
        for (int c = 0; c < 8; ++c) { const float s = bj[c] + ((wj[0][c] * x[i][c] + wj[1][c] * x[i + 1][c]) + (wj[2][c] * x[i + 2][c] + wj[3][c] * x[i + 3][c])); out[i][c] = s * pg8::fast_sigmoid(s); }
}
__device__ __forceinline__ void ml_L(const Args& a, LAS unsigned char* lds, int item, int tid) {
    const int bh = item >> 5, n = item & 31, b = bh >> 2, h = bh & 3, row0 = b * SEQ + n * 64;
    const int lane = tid & 63, w = __builtin_amdgcn_readfirstlane(tid >> 6), fr = lane & 15, fq = lane >> 4;
    if (w == 0) { const float dec = ml_scalars(a, lds, row0, h, lane); if (lane == 0) ((float*)(a.ws + WS_DECM))[bh * 32 + n] = dec; }
    load_vT<256>(lds, (const bf16_t*)(a.ws + WS_MV) + (size_t)row0 * 1024 + h * 256, tid);
    RC_BAR();
    {
        const int oct = tid & 15, tg = tid >> 4;
        float kv[2][8];
        ml_conv8<2>(a, (const bf16_t*)(a.ws + WS_MQK), row0, n * 64, 2 * tg, 512 + h * 128 + oct * 8, kv);
        const LAS float* sc = (const LAS float*)(lds + LSC + 512);
        const float c0 = sc[2 * tg], c1 = sc[2 * tg + 1];
#pragma unroll
        for (int c = 0; c < 8; ++c) *(LAS unsigned*)(lds + LKT + (oct * 8 + c) * 144 + (2 * tg) * 2) = pk2f(kv[0][c] * c0, kv[1][c] * c1);
    }
    RC_BAR();
    if (tid < 128) {
        float s = 0.f;
#pragma unroll
        for (int j = 0; j < 8; ++j) { const v4u q = *(const LAS v4u*)(lds + LKT + tid * 144 + j * 16); s += ((bflo(q.x) + bfhi(q.x)) + (bflo(q.y) + bfhi(q.y))) + ((bflo(q.z) + bfhi(q.z)) + (bflo(q.w) + bfhi(q.w))); }
        ((float*)(a.ws + WS_DNM))[(size_t)(bh * 32 + n) * 128 + tid] = s;
    }
    {
#pragma unroll
        for (int et = 0; et < 2; ++et) {
            bf16x8 fe[2];
#pragma unroll
            for (int ks = 0; ks < 2; ++ks) fe[ks] = *(const LAS bf16x8*)(lds + LVT + (32 * w + 16 * et + fr) * 144 + (8 * fq + 32 * ks) * 2);
            bf16_t* out = (bf16_t*)(a.ws + WS_DCM) + ((size_t)(bh * 32 + n) * 256 + 32 * w + 16 * et + fr) * 128 + 4 * fq;
#pragma unroll
            for (int dt = 0; dt < 8; ++dt) {
                f32x4 acc = (f32x4){0.f, 0.f, 0.f, 0.f};
#pragma unroll
                for (int ks = 0; ks < 2; ++ks) { const bf16x8 fd = *(const LAS bf16x8*)(lds + LKT + (16 * dt + fr) * 144 + (8 * fq + 32 * ks) * 2); acc = RC_MFMA(fd, fe[ks], acc); }
                uint2 o; o.x = pk2f(acc[0], acc[1]); o.y = pk2f(acc[2], acc[3]);
                *(uint2*)(out + 16 * dt) = o;
            }
        }
    }
    RC_BAR();
}
__device__ __forceinline__ void ml_O(const Args& a, LAS unsigned char* lds, int item, int tid) {
    const int bh = item >> 5, n = item & 31, b = bh >> 2, h = bh & 3, row0 = b * SEQ + n * 64;
    const int lane = tid & 63, w = __builtin_amdgcn_readfirstlane(tid >> 6), fr = lane & 15, fq = lane >> 4;
    if (w == 0) (void)ml_scalars(a, lds, row0, h, lane);
    load_vT<256>(lds, (const bf16_t*)(a.ws + WS_MV) + (size_t)row0 * 1024 + h * 256, tid);
    RC_BAR();
    {
        const int oct = tid & 31, tg = tid >> 5, isk = oct >> 4, o8 = (oct & 15) * 8;
        float qv[4][8];
        ml_conv8<4>(a, (const bf16_t*)(a.ws + WS_MQK), row0, n * 64, 4 * tg, isk * 512 + h * 128 + o8, qv);
        const LAS float* sc = (const LAS float*)(lds + LSC + isk * 256);
#pragma unroll
        for (int i = 0; i < 4; ++i) {
            const float s = sc[4 * tg + i];
            v4u o; o.x = pk2f(qv[i][0] * s, qv[i][1] * s); o.y = pk2f(qv[i][2] * s, qv[i][3] * s); o.z = pk2f(qv[i][4] * s, qv[i][5] * s); o.w = pk2f(qv[i][6] * s, qv[i][7] * s);
            *(LAS v4u*)(lds + (isk ? LK : LQ) + (4 * tg + i) * 272 + o8 * 2) = o;
        }
    }
    RC_BAR();
    LAS float* red = (LAS float*)(lds + LRED);
    {
        const int tt = w >> 1;
        bf16x8 fqv[4];
#pragma unroll
        for (int ks = 0; ks < 4; ++ks) fqv[ks] = *(const LAS bf16x8*)(lds + LQ + (16 * tt + fr) * 272 + (8 * fq + 32 * ks) * 2);
#pragma unroll
        for (int j = 0; j < 2; ++j) {
            const int st = 2 * (w & 1) + j;
            f32x4 acc = (f32x4){0.f, 0.f, 0.f, 0.f};
            if (st <= tt) {
#pragma unroll
                for (int ks = 0; ks < 4; ++ks) { const bf16x8 fk = *(const LAS bf16x8*)(lds + LK + (16 * st + fr) * 272 + (8 * fq + 32 * ks) * 2); acc = RC_MFMA(fk, fqv[ks], acc); }
                if (st == tt) {
#pragma unroll
                    for (int r = 0; r < 4; ++r) if (4 * fq + r > fr) acc[r] = 0.f;
                }
            }
            float s = (acc[0] + acc[1]) + (acc[2] + acc[3]);
            s += __shfl_xor(s, 16); s += __shfl_xor(s, 32);
            if (fq == 0) red[(16 * tt + fr) * 4 + st] = s;
            v2u o; o.x = pk2f(acc[0], acc[1]); o.y = pk2f(acc[2], acc[3]);
            *(LAS v2u*)(lds + LAT + (16 * tt + fr) * 144 + (16 * st + 4 * fq) * 2) = o;
        }
        const int t = tid >> 3, part = tid & 7;
        const float* np = (const float*)(a.ws + WS_DNM) + (size_t)(bh * 32 + n) * 128 + part * 16;
        float dsum = 0.f;
#pragma unroll
        for (int j = 0; j < 2; ++j) {
            const v4u q = *(const LAS v4u*)(lds + LQ + t * 272 + (part * 16 + j * 8) * 2);
            const f32x4 n0 = *(const f32x4*)(np + j * 8), n1 = *(const f32x4*)(np + j * 8 + 4);
            dsum += ((bflo(q.x) * n0[0] + bfhi(q.x) * n0[1]) + (bflo(q.y) * n0[2] + bfhi(q.y) * n0[3])) + ((bflo(q.z) * n1[0] + bfhi(q.z) * n1[1]) + (bflo(q.w) * n1[2] + bfhi(q.w) * n1[3]));
        }
        dsum += __shfl_xor(dsum, 1); dsum += __shfl_xor(dsum, 2); dsum += __shfl_xor(dsum, 4);
        if (part == 0) red[256 + t] = dsum;
    }
    RC_BAR();
    {
        f32x4 acc[2][4];
#pragma unroll
        for (int et = 0; et < 2; ++et) {
            bf16x8 fv[2], fc[4];
            const bf16_t* cp = (const bf16_t*)(a.ws + WS_DCM) + ((size_t)(bh * 32 + n) * 256 + 32 * w + 16 * et + fr) * 128 + 8 * fq;
#pragma unroll
            for (int ks = 0; ks < 4; ++ks) fc[ks] = *(const bf16x8*)(cp + 32 * ks);
#pragma unroll
            for (int ks = 0; ks < 2; ++ks) fv[ks] = *(const LAS bf16x8*)(lds + LVT + (32 * w + 16 * et + fr) * 144 + (8 * fq + 32 * ks) * 2);
#pragma unroll
            for (int tt = 0; tt < 4; ++tt) {
                f32x4 c = (f32x4){0.f, 0.f, 0.f, 0.f};
#pragma unroll
                for (int ks = 0; ks < 2; ++ks) { const bf16x8 fa = *(const LAS bf16x8*)(lds + LAT + (16 * tt + fr) * 144 + (8 * fq + 32 * ks) * 2); c = RC_MFMA(fv[ks], fa, c); }
#pragma unroll
                for (int ks = 0; ks < 4; ++ks) { const bf16x8 fqd = *(const LAS bf16x8*)(lds + LQ + (16 * tt + fr) * 272 + (8 * fq + 32 * ks) * 2); c = RC_MFMA(fc[ks], fqd, c); }
                acc[et][tt] = c;
            }
        }
        float dn[4];
#pragma unroll
        for (int tt = 0; tt < 4; ++tt) {
            const int t = 16 * tt + fr;
            const f32x4 rs = *(const LAS f32x4*)(red + t * 4);
            const float den = ((rs[0] + rs[1]) + (rs[2] + rs[3])) + red[256 + t];
            dn[tt] = 1.f / fmaxf(fabsf(den), 1.f);
            float s = 0.f;
#pragma unroll
            for (int et = 0; et < 2; ++et) { acc[et][tt] = acc[et][tt] * dn[tt]; s += (acc[et][tt][0] * acc[et][tt][0] + acc[et][tt][1] * acc[et][tt][1]) + (acc[et][tt][2] * acc[et][tt][2] + acc[et][tt][3] * acc[et][tt][3]); }
            s += __shfl_xor(s, 16); s += __shfl_xor(s, 32);
            if (fq == 0) red[512 + t * 8 + w] = s;
        }
        RC_BAR();
#pragma unroll
        for (int tt = 0; tt < 4; ++tt) {
            const int t = 16 * tt + fr;
            const f32x4 r0 = *(const LAS f32x4*)(red + 512 + t * 8), r1 = *(const LAS f32x4*)(red + 512 + t * 8 + 4);
            const float ss = ((r0[0] + r0[1]) + (r0[2] + r0[3])) + ((r1[0] + r1[1]) + (r1[2] + r1[3]));
            const float rn = 1.f / sqrtf(ss * (1.f / 256.f) + EPS);
#pragma unroll
            for (int et = 0; et < 2; ++et) {
                const int e = 32 * w + 16 * et + 4 * fq;
                const f32x4 gn = *(const f32x4*)(a.ml_norm + h * 256 + e);
                const size_t off = (size_t)(row0 + t) * 1024 + h * 256 + e;
                const uint2 g = *(const uint2*)((const bf16_t*)(a.ws + WS_MO) + off);
                uint2 o;
                o.x = pk2f(acc[et][tt][0] * rn * gn[0] * bflo(g.x), acc[et][tt][1] * rn * gn[1] * bfhi(g.x));
                o.y = pk2f(acc[et][tt][2] * rn * gn[2] * bflo(g.y), acc[et][tt][3] * rn * gn[3] * bfhi(g.y));
                *(uint2*)((bf16_t*)(a.ws + WS_YB) + off) = o;
            }
        }
    }
    RC_BAR();
}

__device__ __forceinline__ void phase_L(const Args& a, const Frame& F) {
#ifndef RC_SKIP_HG
    for (int it = F.vcu; it < 1024; it += F.G) hg_L(a, F.lds + RING_OFF, it, F.tid);
#endif
#ifndef RC_SKIP_ML
    for (int it = F.vcu; it < 512; it += F.G) ml_L(a, F.lds + RING_OFF, it, F.tid);
#endif
}
__device__ __forceinline__ void phase_S(const Args& a, const Frame& F) {
    const int gt = F.vcu * 512 + F.tid, GT = F.G * 512;
#ifndef RC_SKIP_HG
    {
        unsigned* DS = (unsigned*)(a.ws + WS_DSH); const float* DEC = (const float*)(a.ws + WS_DECH);
        for (int p = gt; p < 32 * 128 * 64; p += GT) {
            const int bh = p >> 13, e = (p >> 6) & 127, dp = p & 63;
            unsigned* ds = DS + ((size_t)(bh * 32) * 128 + e) * 64 + dp; const float* dc = DEC + (size_t)(bh * 32) * 128 + 2 * dp;
            float s0 = 0.f, s1 = 0.f;
#pragma unroll 1
            for (int n0 = 0; n0 < 32; n0 += 8) {
                unsigned u[8]; float2 dv[8];
#pragma unroll
                for (int j = 0; j < 8; ++j) { u[j] = ds[(size_t)(n0 + j) * 128 * 64]; dv[j] = *(const float2*)(dc + (size_t)(n0 + j) * 128); }
#pragma unroll
                for (int j = 0; j < 8; ++j) { ds[(size_t)(n0 + j) * 128 * 64] = pk2f(s0, s1); s0 = dv[j].x * s0 + bflo(u[j]); s1 = dv[j].y * s1 + bfhi(u[j]); }
            }
        }
    }
#endif
#ifndef RC_SKIP_ML
    {
        unsigned* DC = (unsigned*)(a.ws + WS_DCM); const float* DEC = (const float*)(a.ws + WS_DECM);
        for (int p = gt; p < 16 * 256 * 64; p += GT) {
            const int bh = p >> 14, e = (p >> 6) & 255, dp = p & 63;
            unsigned* dc = DC + ((size_t)(bh * 32) * 256 + e) * 64 + dp; const float* de = DEC + bh * 32;
            float s0 = 0.f, s1 = 0.f;
#pragma unroll 1
            for (int n0 = 0; n0 < 32; n0 += 8) {
                unsigned u[8]; float dv[8];
#pragma unroll
                for (int j = 0; j < 8; ++j) { u[j] = dc[(size_t)(n0 + j) * 256 * 64]; dv[j] = de[n0 + j]; }
#pragma unroll
                for (int j = 0; j < 8; ++j) { dc[(size_t)(n0 + j) * 256 * 64] = pk2f(s0, s1); s0 = dv[j] * s0 + bflo(u[j]); s1 = dv[j] * s1 + bfhi(u[j]); }
            }
        }
        float* DN = (float*)(a.ws + WS_DNM);
        for (int p = gt; p < 16 * 128; p += GT) {
            const int bh = p >> 7, d = p & 127; float s = 0.f;
            for (int n = 0; n < 32; ++n) { float* q = DN + (size_t)(bh * 32 + n) * 128 + d; const float u = *q; *q = s; s = DEC[bh * 32 + n] * s + u; }
        }
    }
#endif
}
__device__ __forceinline__ void phase_O(const Args& a, const Frame& F) {
#ifndef RC_SKIP_HG
    for (int it = F.vcu; it < 1024; it += F.G) hg_O(a, F.lds + RING_OFF, it, F.tid);
#endif
#ifndef RC_SKIP_ML
    for (int it = F.vcu; it < 512; it += F.G) ml_O(a, F.lds + RING_OFF, it, F.tid);
#endif
}
}
constexpr int N_PHASES = 11;
__global__ void __launch_bounds__(NWAVES * 64, 2) mk_fwd(Args args) {
    extern __shared__ __attribute__((aligned(16))) unsigned char lds_raw[];
    Frame F;
    F.lds = (LAS unsigned char*)lds_raw;
    F.tid = threadIdx.x; F.lane = F.tid & 63; F.wave = __builtin_amdgcn_readfirstlane(F.tid >> 6);
    F.G = gridDim.x; { const int bx = blockIdx.x; F.vcu = (F.G % 8 == 0) ? (bx % 8) * (F.G / 8) + bx / 8 : bx; }
    volatile LAS unsigned* MISC = (volatile LAS unsigned*)(F.lds + MISC_OFF);
    gu32* ctl = (gu32*)(args.ws + WS_CTL);
    for (int u = F.tid; u < (LDS_BYTES - LDSCTL_OFF) / 4; u += NWAVES * 64) ((LAS unsigned*)(F.lds + LDSCTL_OFF))[u] = 0u;
    __syncthreads();
    const int lo = args.ph_lo, hi = args.ph_hi;
    XcdBarrier bar; bar.bar = (unsigned*)(ctl + CW_BAR) + args.li * XCD_BAR_WORDS; bar.x = 0; bar.st = nullptr;
    if (hi - lo > 1) bar = xcd_barrier_post((unsigned*)(ctl + CW_BAR) + args.li * XCD_BAR_WORDS, MISC + 8);
#define IN(k) (lo <= (k) && (k) < hi)
#define FRESH() do { int t_ = threadIdx.x; asm volatile("" : "+v"(t_)); F.tid = t_; F.lane = t_ & 63; } while (0)
#define SEAM(k) do { if (IN(k) && IN((k) + 1)) xcd_barrier(bar); } while (0)
    unsigned char* ws = args.ws;

    if (IN(0))  { FRESH(); phase_prep(args, F); } SEAM(0);

    if (IN(1)) {
        pg8::Gemm g{(const bf16_t*)(ws + WS_HB), nullptr, (const bf16_t*)(ws + WS_WINT), nullptr, 2048};
        pg8::StaticOrder S; S.init(M_TOK, 11264, F.G, (int)blockIdx.x);
        pg8::EpiInProj E{ws, args.b_in};
        pg8::gemm_phase<pg8::EpiInProj, pg8::StaticOrder, true, true>(F.lds + RING_OFF, g, S, E);
    } SEAM(1);

    if (IN(2))  { FRESH(); rc::phase_L(args, F); } SEAM(2);
    if (IN(3))  { FRESH(); rc::phase_S(args, F); } SEAM(3);
    if (IN(4))  { FRESH(); rc::phase_O(args, F); } SEAM(4);

    if (IN(5)) {
        pg8::Gemm g{(const bf16_t*)(ws + WS_YA), (const bf16_t*)(ws + WS_YB), (const bf16_t*)(ws + WS_WA), (const bf16_t*)(ws + WS_WB), 1024};
        pg8::StaticOrder S; S.init(M_TOK, 2048, F.G, (int)blockIdx.x, 2);
        pg8::EpiMerge E{(const bf16_t*)(ws + WS_GA), (const bf16_t*)(ws + WS_GB), (bf16_t*)(ws + WS_MERGED)};
        pg8::gemm_phase<pg8::EpiMerge, pg8::StaticOrder, true, true>(F.lds + RING_OFF, g, S, E);
    } SEAM(5);

    if (IN(6)) {
        pg8::Gemm g{(const bf16_t*)(ws + WS_MERGED), nullptr, (const bf16_t*)(ws + WS_WOUT), nullptr, 2048};
        pg8::StaticOrder S; S.init(M_TOK, 2048, F.G, (int)blockIdx.x);
        pg8::EpiF32 E{(float*)(ws + WS_MIX), 2048};
        pg8::gemm_phase<pg8::EpiF32, pg8::StaticOrder, true, true>(F.lds + RING_OFF, g, S, E);
    } SEAM(6);

    if (IN(7)) {
        FRESH();
        const int gw = F.vcu * NWAVES + F.wave, NGW = F.G * NWAVES;
        for (int m = gw; m < M_TOK; m += NGW) stageF_row(args, m, F.lane);
        phase_ffn_weights(args, F);
    } SEAM(7);

    if (IN(8)) {
        pg8::Gemm g{(const bf16_t*)(ws + WS_H2), nullptr, (const bf16_t*)(ws + WS_WG), nullptr, 2048};
        pg8::StaticOrder S; S.init(M_TOK, 2 * D_FF, F.G, (int)blockIdx.x);
        pg8::EpiGeglu E{(bf16_t*)(ws + WS_UP), (float*)(ws + WS_GTAIL), (float*)(ws + WS_GHEAD), (float*)(ws + WS_UHEAD), args.ffn_conv_w, args.ffn_conv_b, (LAS float*)(F.lds + LDSCTL_OFF + 1024)};
        pg8::gemm_phase<pg8::EpiGeglu, pg8::StaticOrder, true, true>(F.lds + RING_OFF, g, S, E);
    } SEAM(8);

    if (IN(9)) {
        { pg8::StaticOrder S0; S0.init(M_TOK, 2048, F.G, (int)blockIdx.x); pg8::Unit u0; if (S0.next(0, u0)) { FRESH(); geglu_fixup(args, u0.pm, F.tid); } asm volatile("s_waitcnt vmcnt(0)" ::: "memory"); __syncthreads(); }
        pg8::Gemm g{(const bf16_t*)(ws + WS_UP), nullptr, (const bf16_t*)(ws + WS_WD), nullptr, D_FF};
        pg8::StaticOrder S; S.init(M_TOK, 2048, F.G, (int)blockIdx.x);
        pg8::EpiF32 E{(float*)(ws + WS_FFN), 2048};
        pg8::gemm_phase<pg8::EpiF32, pg8::StaticOrder, true, true>(F.lds + RING_OFF, g, S, E);
    } SEAM(9);

    if (IN(10)) {
        FRESH();
        const int gw = F.vcu * NWAVES + F.wave, NGW = F.G * NWAVES;
        for (int m = gw; m < M_TOK; m += NGW) stageJ_row(args, m, F.lane);
    }
#undef IN
#undef SEAM
}

static int g_grid = 0;
static bool fast_init() {
    if (g_grid == 0) {
        int dev = 0, cus = 0;
        if (hipGetDevice(&dev) != hipSuccess || hipDeviceGetAttribute(&cus, hipDeviceAttributeMultiprocessorCount, dev) != hipSuccess) { g_grid = -1; return false; }
        if (hipFuncSetAttribute((const void*)mk_fwd, hipFuncAttributeMaxDynamicSharedMemorySize, LDS_BYTES) != hipSuccess) { fprintf(stderr, "hipFuncSetAttribute failed\n"); g_grid = -1; return false; }
        int per_cu = 0;
        if (hipOccupancyMaxActiveBlocksPerMultiprocessor(&per_cu, (const void*)mk_fwd, NWAVES * 64, LDS_BYTES) != hipSuccess || per_cu < 1) fprintf(stderr, "note: occupancy query says %d\n", per_cu);
        (void)hipGetLastError();
        g_grid = cus;
    }
    return g_grid > 0;
}
static void fast_launch(void* const* d_in, void* d_out, void* d_ws, hipStream_t stream, int lo, int hi, int li) {
    if (!fast_init()) return;
    Args a{};
    const float** dst = (const float**)&a;
    for (int i = 0; i < 20; ++i) dst[i] = (const float*)d_in[i];
    a.out = (float*)d_out; a.ws = (unsigned char*)d_ws; a.ph_lo = lo; a.ph_hi = hi; a.li = li; a.pad = 0;
    hipLaunchKernelGGL(mk_fwd, dim3(g_grid), dim3(NWAVES * 64), LDS_BYTES, stream, a);
}
extern "C" void kernel_launch(void* const* d_in, const int* in_sizes, int n_in, void* d_out, int out_size, void* d_ws, size_t ws_size, hipStream_t stream) {
    if (n_in != 20 || out_size != M_TOK * D_MODEL || ws_size < WS_END) { fprintf(stderr, "kernel_launch: unexpected shapes n_in %d out %d ws %zu\n", n_in, out_size, ws_size); return; }
    (void)hipMemsetAsync((char*)d_ws + WS_CTL, 0, 1 * MiB, stream);
    fast_launch(d_in, d_out, d_ws, stream, 0, N_PHASES, 0);
}
```
